# Optimizing an MI355X kernel written in HIP

```python
import jax, jax.numpy as jnp
from jax import lax
import numpy as np

D_MODEL = 1024
BATCH = 8
SEQ = 4096
DEPTH = 4

CHUNK = 64
N_MEM = 256
NORM_EPS = 1e-6
NEG_BIG = -1e30
GATE_CLIP = 60.0
MIX_WIDTH = D_MODEL
POOL_WIDTH = MIX_WIDTH // 2
POOL_WINDOWS = (2, 4, 8, 16)
POOL_GROUPS = len(POOL_WINDOWS)
POOL_GROUP_DIM = POOL_WIDTH // POOL_GROUPS
REC_WIDTH = MIX_WIDTH - POOL_WIDTH
REC_EXPAND = 128
REC_HEADS = REC_WIDTH // REC_EXPAND
REC_HEAD_DIM = REC_WIDTH // REC_HEADS
ATT_HEADS = 16
ATT_HEAD_DIM = MIX_WIDTH // ATT_HEADS
BAND_CHUNKS = 8
BAND = (BAND_CHUNKS + 1) * CHUNK
REL_CLIP = 256
MEM_HEADS = 4
MEM_HEAD_DIM = D_MODEL // MEM_HEADS
FF_DIM = 4 * D_MODEL
N_EVEN = (DEPTH + 1) // 2
N_ODD = DEPTH // 2

kernel_name = 'hybrid_pool_hgrn2_chunkattn_trunk'


def rmsnorm(x, g):
    xf = x.astype(jnp.float32)
    y = xf * lax.rsqrt(jnp.mean(xf * xf, axis=-1, keepdims=True) + NORM_EPS)
    return y.astype(x.dtype) * g


def causal_multiscale_pool(u):
    S_ = u.shape[1]
    uf = u.astype(jnp.float32)
    cs = jnp.cumsum(uf, axis=1)
    pos = jnp.arange(1, S_ + 1, dtype=jnp.float32)
    outs = []
    for g, w in enumerate(POOL_WINDOWS):
        c = cs[:, :, g]
        lag = jnp.pad(c, ((0, 0), (w, 0), (0, 0)))[:, :S_]
        outs.append((c - lag) / jnp.minimum(pos, w)[:, None])
    mean = jnp.stack(outs, axis=2)
    return (mean - uf).astype(u.dtype)


def hgrn2_chunkwise(q, k, v, logf):
    B_, S_, H, dk = q.shape
    dv = v.shape[-1]
    N = S_ // CHUNK

    def to_chunks(a):
        return a.reshape(B_, N, CHUNK, H, a.shape[-1]).transpose(1, 0, 3, 2, 4)

    causal = jnp.tril(jnp.ones((CHUNK, CHUNK), dtype=bool))[None, None, :, :, None]

    def step(state, inp):
        qc, kc, vc, lc = inp
        b = jnp.cumsum(lc, axis=2)
        o_inter = jnp.einsum('bhtd,bhde->bhte', qc * jnp.exp(b), state)
        diff = b[:, :, :, None, :] - b[:, :, None, :, :]
        decay = jnp.where(causal, jnp.exp(jnp.where(causal, diff, 0.0)), 0.0)
        scores = jnp.einsum('bhtd,bhsd,bhtsd->bhts', qc, kc, decay)
        o = o_inter + jnp.einsum('bhts,bhse->bhte', scores, vc)
        b_last = b[:, :, -1:, :]
        new_state = jnp.exp(b_last[:, :, 0, :])[..., None] * state + jnp.einsum(
            'bhsd,bhse->bhde', kc * jnp.exp(b_last - b), vc)
        return new_state, o

    init = jnp.zeros((B_, H, dk, dv), jnp.float32)
    _, o = lax.scan(step, init, (to_chunks(q), to_chunks(k), to_chunks(v), to_chunks(logf)))
    return o.transpose(1, 0, 3, 2, 4).reshape(B_, S_, H, dv)


def even_mixer(h, w_in, pool_w, pool_scale, lb, out_gain, w_out):
    B_, S_, _ = h.shape
    z = h @ w_in
    cuts = [POOL_WIDTH + r * REC_WIDTH for r in range(4)]
    u, q, fz, i, g = jnp.split(z, cuts, axis=-1)
    pooled = causal_multiscale_pool(u.reshape(B_, S_, POOL_GROUPS, POOL_GROUP_DIM))
    a_out = jnp.einsum('bsgc,gcd->bsgd', pooled, pool_w).reshape(B_, S_, POOL_WIDTH) * pool_scale
    fz32 = jnp.clip(fz.astype(jnp.float32), -GATE_CLIP, GATE_CLIP)
    logf = jax.nn.log_sigmoid(fz32) + jnp.log1p(lb * jnp.exp(-fz32))
    k = (1.0 - lb) * jax.nn.sigmoid(-fz32)
    hs = lambda a: a.reshape(B_, S_, REC_HEADS, -1)
    o = hgrn2_chunkwise(hs(q.astype(jnp.float32)), hs(k), hs(i.astype(jnp.float32)), hs(logf))
    o = rmsnorm(o, out_gain.astype(jnp.float32)) * jax.nn.silu(hs(g.astype(jnp.float32)))
    b_out = o.reshape(B_, S_, REC_WIDTH).astype(h.dtype)
    return jnp.concatenate([a_out.astype(h.dtype), b_out], axis=-1) @ w_out


def chunk_band_attention(q, k, v, rel_bias):
    B_, S_, H, dh = q.shape
    N = S_ // CHUNK
    pad = ((0, 0), (BAND_CHUNKS * CHUNK, 0), (0, 0), (0, 0))
    kp = jnp.pad(k, pad)
    vp = jnp.pad(v, pad)
    t = jnp.arange(CHUNK)[:, None]
    j = jnp.arange(BAND)[None, :]
    rel = BAND_CHUNKS * CHUNK + t - j
    idx = jnp.clip(rel, -REL_CLIP, REL_CLIP) + REL_CLIP
    bias = rel_bias[:, idx].astype(jnp.float32)
    scale = dh ** -0.5

    def per_chunk(n):
        qn = lax.dynamic_slice_in_dim(q, n * CHUNK, CHUNK, axis=1)
        kn = lax.dynamic_slice_in_dim(kp, n * CHUNK, BAND, axis=1)
        vn = lax.dynamic_slice_in_dim(vp, n * CHUNK, BAND, axis=1)
        s = jnp.einsum('bthd,bjhd->bhtj', qn, kn).astype(jnp.float32) * scale + bias
        valid = (n - BAND_CHUNKS) * CHUNK + jnp.arange(BAND) >= 0
        s = jnp.where(valid[None, None, None, :], s, NEG_BIG)
        p = jax.nn.softmax(s, axis=-1).astype(v.dtype)
        return jnp.einsum('bhtj,bjhd->bthd', p, vn)

    out = lax.map(per_chunk, jnp.arange(N))
    return jnp.moveaxis(out, 0, 1).reshape(B_, S_, H, dh)


def odd_mixer(h, w_qkv, rel_bias, w_o):
    B_, S_, _ = h.shape
    qkv = (h @ w_qkv).reshape(B_, S_, 3, ATT_HEADS, ATT_HEAD_DIM)
    o = chunk_band_attention(qkv[:, :, 0], qkv[:, :, 1], qkv[:, :, 2], rel_bias)
    return o.reshape(B_, S_, MIX_WIDTH) @ w_o


def memory_cross_attention(h, mem_n, w_q, w_kv, w_o):
    B_, S_, _ = h.shape
    M = mem_n.shape[1]
    q = (h @ w_q).reshape(B_, S_, MEM_HEADS, MEM_HEAD_DIM)
    kv = (mem_n @ w_kv).reshape(B_, M, 2, MEM_HEADS, MEM_HEAD_DIM)
    s = jnp.einsum('bshd,bmhd->bhsm', q, kv[:, :, 0]).astype(jnp.float32) * MEM_HEAD_DIM ** -0.5
    p = jax.nn.softmax(s, axis=-1).astype(h.dtype)
    o = jnp.einsum('bhsm,bmhd->bshd', p, kv[:, :, 1]).reshape(B_, S_, D_MODEL)
    return o @ w_o


def squared_relu_mlp(h, w1, w2):
    a = jax.nn.relu(h @ w1)
    return (a * a) @ w2


def setup_inputs(seed: int = 0) -> dict:
    key = jax.random.key(seed)
    ks = jax.random.split(key, 20)
    f32 = jnp.float32

    def dense(k, shape):
        return jax.random.normal(k, shape, f32) * shape[-2] ** -0.5

    return {
        'x': jax.random.normal(ks[0], (BATCH, SEQ, D_MODEL), f32),
        'mem': jax.random.normal(ks[1], (BATCH, N_MEM, D_MODEL), f32),
        'norm_gains': 1.0 + 0.05 * jax.random.normal(ks[2], (DEPTH, 6, D_MODEL), f32),
        'mem_norm_gain': 1.0 + 0.05 * jax.random.normal(ks[3], (D_MODEL,), f32),
        'w_in_ab': dense(ks[4], (N_EVEN, D_MODEL, POOL_WIDTH + 4 * REC_WIDTH)),
        'pool_w': dense(ks[5], (N_EVEN, POOL_GROUPS, POOL_GROUP_DIM, POOL_GROUP_DIM)),
        'pool_scale': 1.0 + 0.1 * jax.random.normal(ks[6], (N_EVEN, POOL_WIDTH), f32),
        'rec_lb_logits': 0.1 * jax.random.normal(ks[7], (N_EVEN, REC_WIDTH), f32),
        'rec_out_gain': 1.0 + 0.05 * jax.random.normal(ks[8], (N_EVEN, REC_HEAD_DIM), f32),
        'w_out_ab': dense(ks[9], (N_EVEN, MIX_WIDTH, D_MODEL)),
        'w_qkv': dense(ks[10], (N_ODD, D_MODEL, 3 * MIX_WIDTH)),
        'rel_bias': 0.1 * jax.random.normal(ks[11], (N_ODD, ATT_HEADS, 2 * REL_CLIP + 1), f32),
        'w_o_att': dense(ks[12], (N_ODD, MIX_WIDTH, D_MODEL)),
        'w_mem_q': dense(ks[13], (DEPTH, D_MODEL, D_MODEL)),
        'w_mem_kv': dense(ks[14], (DEPTH, D_MODEL, 2 * D_MODEL)),
        'w_mem_o': dense(ks[15], (DEPTH, D_MODEL, D_MODEL)),
        'w_ff1': dense(ks[16], (DEPTH, D_MODEL, FF_DIM)),
        'w_ff2': dense(ks[17], (DEPTH, FF_DIM, D_MODEL)),
    }


def reference(x, mem, norm_gains, mem_norm_gain, w_in_ab, pool_w, pool_scale, rec_lb_logits,
              rec_out_gain, w_out_ab, w_qkv, rel_bias, w_o_att, w_mem_q, w_mem_kv, w_mem_o,
              w_ff1, w_ff2):
    lb_p = jax.nn.softmax(rec_lb_logits.astype(jnp.float32), axis=0)
    lbs = jnp.clip(jnp.cumsum(lb_p, axis=0) - lb_p[0], 0.0, 1.0)
    mem_n = rmsnorm(mem, mem_norm_gain)
    for l in range(DEPTH):
        g = norm_gains[l]
        h = rmsnorm(x, g[0])
        if l % 2 == 0:
            e = l // 2
            y = even_mixer(h, w_in_ab[e], pool_w[e], pool_scale[e], lbs[e], rec_out_gain[e],
                           w_out_ab[e])
        else:
            o = l // 2
            y = odd_mixer(h, w_qkv[o], rel_bias[o], w_o_att[o])
        x = x + rmsnorm(y, g[1])
        h = rmsnorm(x, g[2])
        x = x + rmsnorm(memory_cross_attention(h, mem_n, w_mem_q[l], w_mem_kv[l], w_mem_o[l]), g[3])
        h = rmsnorm(x, g[4])
        x = x + rmsnorm(squared_relu_mlp(h, w_ff1[l], w_ff2[l]), g[5])
    return x
```

```cpp
#include <hip/hip_runtime.h>
#include <hip/hip_cooperative_groups.h>
#include <cstdio>
#include <cstdint>
namespace cg = cooperative_groups;
namespace pg8 {
#define PG8_LAS __attribute__((address_space(3)))
typedef unsigned short bf16_t;
typedef short bf16x8 __attribute__((ext_vector_type(8)));
typedef float f32x4 __attribute__((ext_vector_type(4)));
typedef unsigned u32x4 __attribute__((ext_vector_type(4)));
constexpr int BM = 256, BK = 64, HALF = 128, HTB = HALF * BK * 2  , STAGE_BYTES = 8 * HTB, NXCD = 8, WGM = 8;

__host__ __device__ __forceinline__ int lds_byte(int r, int c) { const int st = (r >> 4) * 2 + (c >> 5), rr = r & 15, cc = c & 31, ob = rr * 64 + cc * 2; return st * 1024 + (ob ^ (((ob >> 9) & 1) << 5)); }
__host__ __device__ __forceinline__ void stage_rc(int b, int& R, int& C) { const int st = b / 1024, sb = b % 1024, swz = sb ^ (((sb >> 9) & 1) << 5); R = (st >> 1) * 16 + swz / 64; C = (st & 1) * 32 + (swz % 64) / 2; }
__host__ __device__ __forceinline__ int perm32(int rho) { const int n = rho >> 4, i = rho & 15; return 8 * (i >> 2) + 4 * n + (i & 3); }

struct Unit { int pm, pn; };
struct Gemm { const bf16_t* A; const bf16_t* Bt; int M, N, K; };

struct StaticOrder {
    int nM, nN, nwg, G, c;
    __host__ __device__ void init(int M, int N, int G_, int c_) { nM = M / BM; nN = N / BM; nwg = nM * nN; G = G_; c = c_; }
    __host__ __device__ bool next(int i, Unit& u) const {
        const long L = (long)i * G + c; if (L >= nwg) return false;
        int wgid = (int)L; { const int q = nwg / NXCD, r = nwg % NXCD, xcd = wgid % NXCD, off = wgid / NXCD; wgid = (xcd < r ? xcd * (q + 1) : r * (q + 1) + (xcd - r) * q) + off; }
        const int nig = WGM * nN, gid = wgid / nig, fm = gid * WGM, gsz = (nM - fm) < WGM ? (nM - fm) : WGM;
        u.pm = fm + ((wgid % nig) % gsz); u.pn = (wgid % nig) / gsz; return true;
    }
    __device__ __forceinline__ void a_ready(const Unit&) const {}
    __device__ __forceinline__ void done(const Unit&) const {}
};
__device__ __forceinline__ unsigned cvt_pk_bf16(float lo, float hi) { unsigned r; asm volatile("v_cvt_pk_bf16_f32 %0, %1, %2" : "=v"(r) : "v"(lo), "v"(hi)); return r; }
typedef float f32x2 __attribute__((ext_vector_type(2)));
template <class Epi, class Sched, bool ALIGN_EPI = false, bool SP2 = false>
__device__ __forceinline__ void gemm_phase(PG8_LAS unsigned char* lds, const Gemm g, const Sched& S, const Epi& E) {
    int tid_l = threadIdx.x; asm volatile("" : "+v"(tid_l));
    const int tid = tid_l, wid = __builtin_amdgcn_readfirstlane(tid >> 6), lane = tid & 63, wr = wid >> 2, wc = wid & 3, fr = lane & 15, fq = lane >> 4;
    const int K = g.K, nt = K / BK;
    unsigned voffA[2], voffB[2];
#pragma unroll
    for (int i = 0; i < 2; ++i) { int R, C; stage_rc(tid * 16 + i * 8192, R, C); const int Rb = Epi::PERM ? ((R & ~31) + perm32(R & 31)) : R;
        voffA[i] = (unsigned)(R * K + C) * 2u; voffB[i] = (unsigned)(Rb * K + C) * 2u; }
    const size_t kstep = (size_t)(BK * 2);
    const size_t hstep = (size_t)HALF * K * 2;
    const size_t tstep = 2 * hstep;
    const unsigned ldsw = (unsigned)wid * 1024u;
    const int aoff = lds_byte(wr * 64 + fr, fq * 8), boff = lds_byte(wc * 32 + fr, fq * 8);
#define PG8_SA(b, h) (((b) * 2 + (h)) * HTB)
#define PG8_SB(b, h) ((4 + (b) * 2 + (h)) * HTB)
#define PG8_STAGE(bufoff, gbase, voff) do { _Pragma("unroll") for (int _i = 0; _i < 2; ++_i) \
        __builtin_amdgcn_global_load_lds((const unsigned*)((const char*)(gbase) + (voff)[_i]), (PG8_LAS unsigned*)(lds + (bufoff) + ldsw + _i * 8192), 16, 0, 0); } while (0)
#define PG8_LDA(dst, b, h) do { _Pragma("unroll") for (int m = 0; m < 4; ++m) _Pragma("unroll") for (int k = 0; k < 2; ++k) dst[m][k] = *(const PG8_LAS bf16x8*)(lds + PG8_SA(b, h) + aoff + m * 2048 + k * 1024); } while (0)
#define PG8_LDB(dst, b, h) do { _Pragma("unroll") for (int n = 0; n < 2; ++n) _Pragma("unroll") for (int k = 0; k < 2; ++k) dst[n][k] = *(const PG8_LAS bf16x8*)(lds + PG8_SB(b, h) + boff + n * 2048 + k * 1024); } while (0)
#define PG8_MMA(ai, bj, At, Bt) do { __builtin_amdgcn_s_setprio(1); _Pragma("unroll") for (int m = 0; m < 4; ++m) _Pragma("unroll") for (int n = 0; n < 2; ++n) _Pragma("unroll") for (int k = 0; k < 2; ++k) \
        acc[ai][bj][m][n] = __builtin_amdgcn_mfma_f32_16x16x32_bf16(Bt[n][k], At[m][k], acc[ai][bj][m][n], 0, 0, 0); __builtin_amdgcn_s_setprio(0); } while (0)
#define PG8_WAIT_V(n) asm volatile("s_waitcnt vmcnt(" #n ")" ::: "memory")
#define PG8_WAIT_L(n) asm volatile("s_waitcnt lgkmcnt(" #n ")" ::: "memory")
#define PG8_BAR __builtin_amdgcn_s_barrier()
#define PG8_SCHED __builtin_amdgcn_sched_barrier(0)
    Unit cur, nxt; int ui = 0;
    if (!S.next(0, cur)) return;
    f32x4 acc[2][2][4][2];
#pragma unroll
    for (int a = 0; a < 2; ++a)
#pragma unroll
        for (int b = 0; b < 2; ++b)
#pragma unroll
            for (int m = 0; m < 4; ++m)
#pragma unroll
                for (int n = 0; n < 2; ++n) acc[a][b][m][n] = (f32x4){0.f, 0.f, 0.f, 0.f};
    bf16x8 At[4][2], B0[2][2], B1[2][2];
    const char* cA = (const char*)g.A + (size_t)cur.pm * tstep; const char* cB = (const char*)g.Bt + (size_t)cur.pn * tstep;
    S.a_ready(cur);
    if constexpr (SP2) {
        PG8_STAGE(PG8_SB(0, 0), cB, voffB); PG8_STAGE(PG8_SB(0, 1), cB + hstep, voffB); PG8_STAGE(PG8_SA(0, 0), cA, voffA); PG8_STAGE(PG8_SA(0, 1), cA + hstep, voffA);
        if (wr == 1) PG8_BAR;
        PG8_WAIT_V(2); PG8_BAR;
        PG8_STAGE(PG8_SB(1, 0), cB + kstep, voffB); PG8_STAGE(PG8_SA(1, 0), cA + kstep, voffA); PG8_STAGE(PG8_SB(1, 1), cB + hstep + kstep, voffB);
        PG8_WAIT_V(6); PG8_BAR;
    } else {
        PG8_STAGE(PG8_SB(0, 0), cB, voffB); PG8_STAGE(PG8_SA(0, 0), cA, voffA); PG8_STAGE(PG8_SB(0, 1), cB + hstep, voffB); PG8_STAGE(PG8_SA(0, 1), cA + hstep, voffA);
        if (wr == 1) PG8_BAR;
        PG8_WAIT_V(4); PG8_BAR;
        PG8_STAGE(PG8_SB(1, 0), cB + kstep, voffB); PG8_STAGE(PG8_SA(1, 0), cA + kstep, voffA); PG8_STAGE(PG8_SB(1, 1), cB + hstep + kstep, voffB);
        PG8_WAIT_V(6); PG8_BAR;
    }
    for (;;) {
        const bool has_next = S.next(ui + 1, nxt);
        const char* nA = has_next ? (const char*)g.A + (size_t)nxt.pm * tstep : cA; const char* nB = has_next ? (const char*)g.Bt + (size_t)nxt.pn * tstep : cB;
        for (int t = 0; t < nt; t += 2) {
            const bool last = (t == nt - 2);
            const char* a1 = cA + (size_t)(t + 1) * kstep;
            const char* a2 = last ? nA : cA + (size_t)(t + 2) * kstep; const char* b2 = last ? nB : cB + (size_t)(t + 2) * kstep;
            const char* a3 = a2 + kstep; const char* b3 = b2 + kstep;
            if (last && has_next) S.a_ready(nxt);
            if constexpr (SP2) {
            PG8_LDB(B0, 0, 0); PG8_LDB(B1, 0, 1); PG8_SCHED; PG8_LDA(At, 0, 0); PG8_STAGE(PG8_SA(1, 1), a1 + hstep, voffA);
            PG8_WAIT_V(8); PG8_WAIT_L(0); PG8_BAR; PG8_MMA(0, 0, At, B0); PG8_MMA(0, 1, At, B1); PG8_BAR; PG8_SCHED;
            PG8_LDA(At, 0, 1); PG8_STAGE(PG8_SB(0, 0), b2, voffB); PG8_STAGE(PG8_SB(0, 1), b2 + hstep, voffB); PG8_STAGE(PG8_SA(0, 0), a2, voffA);
            PG8_WAIT_V(8); PG8_WAIT_L(0); PG8_BAR; PG8_MMA(1, 0, At, B0); PG8_MMA(1, 1, At, B1); PG8_BAR; PG8_SCHED;
            PG8_LDB(B0, 1, 0); PG8_LDB(B1, 1, 1); PG8_SCHED; PG8_LDA(At, 1, 0); PG8_STAGE(PG8_SA(0, 1), a2 + hstep, voffA);
            PG8_WAIT_V(8); PG8_WAIT_L(0); PG8_BAR; PG8_MMA(0, 0, At, B0); PG8_MMA(0, 1, At, B1); PG8_BAR; PG8_SCHED;
            PG8_LDA(At, 1, 1); PG8_STAGE(PG8_SB(1, 0), b3, voffB); PG8_STAGE(PG8_SB(1, 1), b3 + hstep, voffB); PG8_STAGE(PG8_SA(1, 0), a3, voffA);
            PG8_WAIT_V(8); PG8_WAIT_L(0); PG8_BAR; PG8_MMA(1, 0, At, B0); PG8_MMA(1, 1, At, B1); PG8_BAR; PG8_SCHED;
            } else {
            PG8_LDB(B0, 0, 0); PG8_SCHED; PG8_LDA(At, 0, 0); PG8_STAGE(PG8_SA(1, 1), a1 + hstep, voffA);
            PG8_WAIT_L(8); PG8_BAR; PG8_WAIT_L(0); PG8_MMA(0, 0, At, B0); PG8_BAR; PG8_SCHED;
            PG8_LDB(B1, 0, 1); PG8_STAGE(PG8_SB(0, 0), b2, voffB);
            PG8_BAR; PG8_WAIT_L(0); PG8_MMA(0, 1, At, B1); PG8_BAR;
            PG8_LDA(At, 0, 1); PG8_STAGE(PG8_SA(0, 0), a2, voffA);
            PG8_BAR; PG8_WAIT_L(0); PG8_MMA(1, 0, At, B0); PG8_BAR; PG8_SCHED;
            PG8_STAGE(PG8_SB(0, 1), b2 + hstep, voffB);
            PG8_WAIT_V(6); PG8_BAR; PG8_MMA(1, 1, At, B1); PG8_BAR;
            PG8_LDB(B0, 1, 0); PG8_SCHED; PG8_LDA(At, 1, 0); PG8_STAGE(PG8_SA(0, 1), a2 + hstep, voffA);
            PG8_WAIT_L(8); PG8_BAR; PG8_WAIT_L(0); PG8_MMA(0, 0, At, B0); PG8_BAR; PG8_SCHED;
            PG8_LDB(B1, 1, 1); PG8_STAGE(PG8_SB(1, 0), b3, voffB);
            PG8_BAR; PG8_WAIT_L(0); PG8_MMA(0, 1, At, B1); PG8_BAR;
            PG8_LDA(At, 1, 1); PG8_STAGE(PG8_SA(1, 0), a3, voffA);
            PG8_BAR; PG8_WAIT_L(0); PG8_MMA(1, 0, At, B0); PG8_BAR; PG8_SCHED;
            PG8_STAGE(PG8_SB(1, 1), b3 + hstep, voffB);
            PG8_WAIT_V(6); PG8_BAR; PG8_MMA(1, 1, At, B1); PG8_BAR;
            }
        }
        if constexpr (ALIGN_EPI) { if (wr == 0) PG8_BAR; }
        if constexpr (!Epi::AFTER_DRAIN) { E(acc, cur, wr, wc, fr, fq); S.done(cur); }
        if (!has_next) break;
#pragma unroll
        for (int a = 0; a < 2; ++a)
#pragma unroll
            for (int b = 0; b < 2; ++b)
#pragma unroll
                for (int m = 0; m < 4; ++m)
#pragma unroll
                    for (int n = 0; n < 2; ++n) acc[a][b][m][n] = (f32x4){0.f, 0.f, 0.f, 0.f};
        cur = nxt; cA = nA; cB = nB; ++ui;
        if constexpr (ALIGN_EPI) { if (wr == 1) PG8_BAR; }
    }
    PG8_WAIT_V(0);
    if constexpr (!ALIGN_EPI) { if (wr == 0) PG8_BAR; }
    PG8_BAR;
    if constexpr (Epi::AFTER_DRAIN) { E.fused(acc, cur, wr, wc, fr, fq, lds, wid, lane); S.done(cur); }
#undef PG8_SA
#undef PG8_SB
#undef PG8_STAGE
#undef PG8_LDA
#undef PG8_LDB
#undef PG8_MMA
#undef PG8_WAIT_V
#undef PG8_WAIT_L
#undef PG8_BAR
#undef PG8_SCHED
}
}
#ifndef PG8_SP2
#define PG8_SP2 true
#endif
#ifndef PG8_ALIGN
#define PG8_ALIGN true
#endif
constexpr int D = 1024, BATCH = 8, SEQ = 4096, T = BATCH * SEQ, FF = 4096, ZW = 2560;
constexpr float EPS = 1e-6f;
constexpr int NTHR = 512;
constexpr int LDS_BYTES = 147456;
constexpr size_t MiB = 1u << 20;
constexpr size_t WS_W = 0;
constexpr size_t WL_STRIDE = 14 * MiB;
constexpr size_t WL_MIXIN = 0, WL_MIXOUT = 3 * MiB, WL_MEMQ = 4 * MiB, WL_MEMO = 5 * MiB, WL_FF1 = 6 * MiB, WL_FF2 = 10 * MiB;
constexpr size_t W_MEMKV = 56 * MiB;
constexpr size_t WS_H = 128 * MiB;
constexpr size_t WS_R = 192 * MiB;
constexpr size_t WS_MK = 448 * MiB;
constexpr size_t WS_MV = 464 * MiB;
constexpr size_t WS_MEMN = 480 * MiB;
constexpr size_t WS_DEC = 484 * MiB;
constexpr size_t WS_PAR = 485 * MiB;
constexpr int PAR_GAINS = 0, PAR_LBL = 24576, PAR_OG = 25600, PAR_RELB = 25856, PAR_N = 25856 + 2 * 16 * 513;
constexpr size_t WS_END = 486 * MiB;

#define LAS __attribute__((address_space(3)))
typedef unsigned short bf16;
typedef short bf16x8 __attribute__((ext_vector_type(8)));
typedef float f32x4 __attribute__((ext_vector_type(4)));
typedef unsigned u32x4 __attribute__((ext_vector_type(4)));
typedef unsigned u32x2 __attribute__((ext_vector_type(2)));
#define LDS_WAIT() asm volatile("s_waitcnt lgkmcnt(0)" ::: "memory")

__device__ __forceinline__ unsigned f2bf(float f) { unsigned u = __float_as_uint(f); return (u + 0x7fffu + ((u >> 16) & 1u)) >> 16; }
__device__ __forceinline__ unsigned pk2(float lo, float hi) { return f2bf(lo) | (f2bf(hi) << 16); }
__device__ __forceinline__ float bflo(unsigned w) { return __uint_as_float(w << 16); }
__device__ __forceinline__ float bfhi(unsigned w) { return __uint_as_float(w & 0xffff0000u); }
__device__ __forceinline__ float bf1(bf16 b) { return __uint_as_float(((unsigned)b) << 16); }
__device__ __forceinline__ f32x4 mfma16(bf16x8 a, bf16x8 b, f32x4 c) { return __builtin_amdgcn_mfma_f32_16x16x32_bf16(a, b, c, 0, 0, 0); }
__device__ __forceinline__ float wave_sum(float v) {
#pragma unroll
    for (int o = 1; o < 64; o <<= 1) v += __shfl_xor(v, o);
    return v;
}

template <int MODE> struct Epi {
    static constexpr bool PERM = true, AFTER_DRAIN = false;
    bf16* O0; bf16* O1; bf16* O2; int ldc; float scale;
    __device__ __forceinline__ void operator()(const pg8::f32x4 (&acc)[2][2][4][2], const pg8::Unit& u, int wr, int wc, int fr, int fq) const {
        const int row0 = u.pm * 256 + wr * 64 + fr, colb = u.pn * 256 + wc * 32 + 8 * fq;
#pragma unroll
        for (int ai = 0; ai < 2; ++ai)
#pragma unroll
            for (int m = 0; m < 4; ++m) {
                const int row = row0 + ai * 128 + m * 16;
#pragma unroll
                for (int bj = 0; bj < 2; ++bj) {
                    const int col = colb + bj * 128;
                    pg8::f32x4 v0 = acc[ai][bj][m][0], v1 = acc[ai][bj][m][1];
                    if (MODE == 0) { v0 = v0 * scale; v1 = v1 * scale; }
                    if (MODE == 1) {
#pragma unroll
                        for (int j = 0; j < 4; ++j) { const float a = fmaxf(v0[j], 0.f), b = fmaxf(v1[j], 0.f); v0[j] = a * a; v1[j] = b * b; }
                    }
                    if (MODE == 2 && (u.pn >> 2) == 0) { v0 = v0 * scale; v1 = v1 * scale; }
                    u32x4 w; w.x = pk2(v0[0], v0[1]); w.y = pk2(v0[2], v0[3]); w.z = pk2(v1[0], v1[1]); w.w = pk2(v1[2], v1[3]);
                    if (MODE == 0 || MODE == 1) { *(u32x4*)(O0 + (size_t)row * ldc + col) = w; }
                    if (MODE == 2) {
                        const int t = u.pn >> 2, c = col - t * 1024;
                        if (t == 0) *(u32x4*)(O0 + (size_t)row * 1024 + c) = w;
                        else if (t == 1) *(u32x4*)(O1 + (size_t)row * 1024 + c) = w;
                        else {
                            const int sq = row & 4095, cv = c;
                            bf16* vp = O2 + ((((size_t)((row >> 12) * 16 + (cv >> 6))) * 1024 + (sq >> 2)) * 64 + (cv & 63)) * 4 + (sq & 3);
                            vp[0] = (bf16)(w.x & 0xffff); vp[4] = (bf16)(w.x >> 16); vp[8] = (bf16)(w.y & 0xffff); vp[12] = (bf16)(w.y >> 16);
                            vp[16] = (bf16)(w.z & 0xffff); vp[20] = (bf16)(w.z >> 16); vp[24] = (bf16)(w.w & 0xffff); vp[28] = (bf16)(w.w >> 16);
                        }
                    }
                    if (MODE == 3) {
                        const int l = col >> 11, cc = col & 2047;
                        if (cc < 1024) *(u32x4*)(O0 + ((size_t)l * 2048 + row) * 1024 + cc) = w;
                        else {
                            const int mq = row & 255, cv = cc - 1024;
                            bf16* vp = O1 + (((((size_t)l * 8 + (row >> 8)) * 4 + (cv >> 8)) * 64 + (mq >> 2)) * 256 + (cv & 255)) * 4 + (mq & 3);
                            vp[0] = (bf16)(w.x & 0xffff); vp[4] = (bf16)(w.x >> 16); vp[8] = (bf16)(w.y & 0xffff); vp[12] = (bf16)(w.y >> 16);
                            vp[16] = (bf16)(w.z & 0xffff); vp[20] = (bf16)(w.z >> 16); vp[24] = (bf16)(w.w & 0xffff); vp[28] = (bf16)(w.w >> 16);
                        }
                    }
                }
            }
    }
};

template <int MODE>
__device__ __forceinline__ void run_gemm(LAS unsigned char* lds, const bf16* A, const bf16* Bt, int M, int N, int K, bf16* O0, bf16* O1, bf16* O2, int ldc, float scale) {
    const int gsz = (int)gridDim.x, cid = (int)blockIdx.x;
    pg8::Gemm g{A, Bt, M, N, K}; pg8::StaticOrder S; S.init(M, N, gsz, cid);
    Epi<MODE> E{O0, O1, O2, ldc, scale};
    pg8::gemm_phase<Epi<MODE>, pg8::StaticOrder, PG8_ALIGN, PG8_SP2>(lds, g, S, E);
}

__device__ __forceinline__ void transpose_item(const float* W, int ldw, int nblk, bf16* WT, int ldt, LAS float* scr, int item, int lane) {
    const int kb = item / nblk, nb = item % nblk, k0 = 64 * kb, n0 = 32 * nb;
#pragma unroll 8
    for (int i = 0; i < 32; ++i) { const int kk = 2 * i + (lane >> 5); scr[kk * 33 + (lane & 31)] = W[(size_t)(k0 + kk) * ldw + n0 + (lane & 31)]; }
    LDS_WAIT(); asm volatile("" ::: "memory");
    const int c = lane & 7;
#pragma unroll
    for (int j = 0; j < 4; ++j) { const int n = (lane >> 3) + 8 * j; const LAS float* s = scr + (8 * c) * 33 + n;
        u32x4 o; o.x = pk2(s[0 * 33], s[1 * 33]); o.y = pk2(s[2 * 33], s[3 * 33]); o.z = pk2(s[4 * 33], s[5 * 33]); o.w = pk2(s[6 * 33], s[7 * 33]);
        *(u32x4*)(WT + (size_t)(n0 + n) * ldt + k0 + 8 * c) = o; }
    LDS_WAIT(); asm volatile("" ::: "memory");
}
__device__ __forceinline__ void rms_row_to_bf16(const float* xrow, const float* gain, bf16* orow, int lane) {
    float ss = 0.f; f32x4 v[4];
#pragma unroll
    for (int j = 0; j < 4; ++j) { v[j] = *(const f32x4*)(xrow + j * 256 + lane * 4); ss += (v[j].x * v[j].x + v[j].y * v[j].y) + (v[j].z * v[j].z + v[j].w * v[j].w); }
    const float r = rsqrtf(wave_sum(ss) * (1.f / D) + EPS);
#pragma unroll
    for (int j = 0; j < 4; ++j) { const f32x4 g = *(const f32x4*)(gain + j * 256 + lane * 4);
        u32x2 o; o.x = pk2(v[j].x * r * g.x, v[j].y * r * g.y); o.y = pk2(v[j].z * r * g.z, v[j].w * r * g.w);
        *(u32x2*)(orow + j * 256 + lane * 4) = o; }
}

__device__ __forceinline__ void sweep_phase(const bf16* y, const float* xin, float* xout, const float* ga, const float* gb, bf16* hout) {
    int tid = threadIdx.x; asm volatile("" : "+v"(tid)); const int lane = tid & 63, wave = __builtin_amdgcn_readfirstlane(tid >> 6); (void)lane; (void)wave;
    const int gw = blockIdx.x * 8 + wave, ngw = gridDim.x * 8;
    for (int row = gw; row < T; row += ngw) {
        const bf16* yr = y + (size_t)row * D; const float* xr = xin + (size_t)row * D; float* xo = xout + (size_t)row * D;
        float yv[2][8], xv[2][8]; float ss = 0.f;
#pragma unroll
        for (int j = 0; j < 2; ++j) {
            const u32x4 w = *(const u32x4*)(yr + j * 512 + lane * 8);
            yv[j][0] = bflo(w.x); yv[j][1] = bfhi(w.x); yv[j][2] = bflo(w.y); yv[j][3] = bfhi(w.y); yv[j][4] = bflo(w.z); yv[j][5] = bfhi(w.z); yv[j][6] = bflo(w.w); yv[j][7] = bfhi(w.w);
            const f32x4 a = *(const f32x4*)(xr + j * 512 + lane * 8), b = *(const f32x4*)(xr + j * 512 + lane * 8 + 4);
            xv[j][0] = a.x; xv[j][1] = a.y; xv[j][2] = a.z; xv[j][3] = a.w; xv[j][4] = b.x; xv[j][5] = b.y; xv[j][6] = b.z; xv[j][7] = b.w;
#pragma unroll
            for (int i = 0; i < 8; ++i) ss += yv[j][i] * yv[j][i];
        }
        const float r1 = rsqrtf(wave_sum(ss) * (1.f / D) + EPS);
        float s2 = 0.f;
#pragma unroll
        for (int j = 0; j < 2; ++j) {
            const f32x4 g0 = *(const f32x4*)(ga + j * 512 + lane * 8), g1 = *(const f32x4*)(ga + j * 512 + lane * 8 + 4);
            const float gg[8] = {g0.x, g0.y, g0.z, g0.w, g1.x, g1.y, g1.z, g1.w};
#pragma unroll
            for (int i = 0; i < 8; ++i) { xv[j][i] = xv[j][i] + yv[j][i] * r1 * gg[i]; s2 += xv[j][i] * xv[j][i]; }
            *(f32x4*)(xo + j * 512 + lane * 8) = (f32x4){xv[j][0], xv[j][1], xv[j][2], xv[j][3]};
            *(f32x4*)(xo + j * 512 + lane * 8 + 4) = (f32x4){xv[j][4], xv[j][5], xv[j][6], xv[j][7]};
        }
        if (hout) {
            const float r2 = rsqrtf(wave_sum(s2) * (1.f / D) + EPS);
#pragma unroll
            for (int j = 0; j < 2; ++j) {
                const f32x4 g0 = *(const f32x4*)(gb + j * 512 + lane * 8), g1 = *(const f32x4*)(gb + j * 512 + lane * 8 + 4);
                u32x4 o; o.x = pk2(xv[j][0] * r2 * g0.x, xv[j][1] * r2 * g0.y); o.y = pk2(xv[j][2] * r2 * g0.z, xv[j][3] * r2 * g0.w);
                o.z = pk2(xv[j][4] * r2 * g1.x, xv[j][5] * r2 * g1.y); o.w = pk2(xv[j][6] * r2 * g1.z, xv[j][7] * r2 * g1.w);
                *(u32x4*)(hout + (size_t)row * D + j * 512 + lane * 8) = o;
            }
        }
    }
}

__device__ __forceinline__ void band_attn_phase(LAS unsigned char* lds, const bf16* q, const bf16* k, const bf16* vT, const float* relb, bf16* mout) {
    int tid = threadIdx.x; asm volatile("" : "+v"(tid)); const int lane = tid & 63, wave = __builtin_amdgcn_readfirstlane(tid >> 6); (void)lane; (void)wave;
    LAS float* biasL = (LAS float*)lds;
    const int fr = lane & 15, fq = lane >> 4;
    for (int p = blockIdx.x; p < 4096; p += gridDim.x) {
        const int unit = 2 * p + (wave >> 2), n = unit & 63, bh = unit >> 6, h = bh & 15, b = bh >> 4;
        __syncthreads();
        for (int i = tid; i < 513; i += NTHR) biasL[i] = relb[h * 513 + i];
        __syncthreads();
        const int t0 = (wave & 3) * 16;
        const size_t qrow = (size_t)b * 4096 + n * 64 + t0 + fr;
        bf16x8 Qf[2];
#pragma unroll
        for (int ks = 0; ks < 2; ++ks) Qf[ks] = *(const bf16x8*)(q + qrow * 1024 + h * 64 + ks * 32 + fq * 8);
        f32x4 O[4];
#pragma unroll
        for (int dt = 0; dt < 4; ++dt) O[dt] = (f32x4){0.f, 0.f, 0.f, 0.f};
        float mrow = -1e30f, lrow = 0.f;
        const int jb0 = (n < 8) ? 8 - n : 0;
#pragma unroll 1
        for (int jb = jb0; jb < 9; ++jb) {
            const int kc = n - 8 + jb;
            const bf16* klane = k + ((size_t)b * 4096 + kc * 64 + fr) * 1024 + h * 64 + fq * 8; asm volatile("" : "+v"(klane));
            const bf16* vlane = vT + ((((size_t)(b * 16 + h)) * 1024 + kc * 16 + fq) * 64 + fr) * 4; asm volatile("" : "+v"(vlane));
            f32x4 S[4];
#pragma unroll
            for (int kt = 0; kt < 4; ++kt) {
                S[kt] = (f32x4){0.f, 0.f, 0.f, 0.f};
                const bf16* kp = klane + kt * 16 * 1024; asm volatile("" : "+v"(kp));
#pragma unroll
                for (int ks = 0; ks < 2; ++ks) { const bf16x8 Kf = *(const bf16x8*)(kp + ks * 32); S[kt] = mfma16(Kf, Qf[ks], S[kt]); }
            }
            float mx = -1e30f;
#pragma unroll
            for (int kt = 0; kt < 4; ++kt)
#pragma unroll
                for (int r = 0; r < 4; ++r) {
                    int rel = (8 - jb) * 64 + (t0 + fr) - (kt * 16 + 4 * fq + r);
                    rel = rel < -256 ? -256 : (rel > 256 ? 256 : rel);
                    const float s = S[kt][r] + biasL[rel + 256]; S[kt][r] = s; mx = fmaxf(mx, s);
                }
            mx = fmaxf(mx, __shfl_xor(mx, 16)); mx = fmaxf(mx, __shfl_xor(mx, 32));
            const float mnew = fmaxf(mrow, mx), alpha = __expf(mrow - mnew);
            float rs = 0.f;
#pragma unroll
            for (int kt = 0; kt < 4; ++kt)
#pragma unroll
                for (int r = 0; r < 4; ++r) { const float pz = __expf(S[kt][r] - mnew); S[kt][r] = pz; rs += pz; }
            rs += __shfl_xor(rs, 16); rs += __shfl_xor(rs, 32);
            lrow = lrow * alpha + rs; mrow = mnew;
#pragma unroll
            for (int dt = 0; dt < 4; ++dt) O[dt] = O[dt] * alpha;
#pragma unroll
            for (int a = 0; a < 2; ++a) {
                u32x4 pw; pw.x = pk2(S[2 * a][0], S[2 * a][1]); pw.y = pk2(S[2 * a][2], S[2 * a][3]); pw.z = pk2(S[2 * a + 1][0], S[2 * a + 1][1]); pw.w = pk2(S[2 * a + 1][2], S[2 * a + 1][3]);
                const bf16x8 Pf = __builtin_bit_cast(bf16x8, pw);
#pragma unroll
                for (int dt = 0; dt < 4; ++dt) {
                    const bf16* vp = vlane + a * 2048 + dt * 64;
                    const u32x2 lo = *(const u32x2*)vp, hi = *(const u32x2*)(vp + 1024);
                    const bf16x8 Vf = __builtin_bit_cast(bf16x8, (u32x4){lo.x, lo.y, hi.x, hi.y});
                    O[dt] = mfma16(Vf, Pf, O[dt]);
                }
            }
        }
        const float inv = 1.f / lrow;
#pragma unroll
        for (int dt = 0; dt < 4; ++dt) { u32x2 o; o.x = pk2(O[dt][0] * inv, O[dt][1] * inv); o.y = pk2(O[dt][2] * inv, O[dt][3] * inv);
            *(u32x2*)(mout + qrow * 1024 + h * 64 + dt * 16 + 4 * fq) = o; }
    }
}

__device__ __forceinline__ void cross_attn_phase(const bf16* qm, const bf16* Km, const bf16* VTm, bf16* oout) {
    int tid = threadIdx.x; asm volatile("" : "+v"(tid)); const int lane = tid & 63, wave = __builtin_amdgcn_readfirstlane(tid >> 6); (void)lane; (void)wave;
    const int fr = lane & 15, fq = lane >> 4;
    for (int bu = blockIdx.x; bu < 1024; bu += gridDim.x) {
        const int bhm = bu >> 5, hm = bhm & 3, b = bhm >> 2;
        const size_t qrow = (size_t)b * 4096 + (bu & 31) * 128 + wave * 16 + fr;
        bf16x8 Qf[8];
        const bf16* qlane = qm + qrow * 1024 + hm * 256 + fq * 8; asm volatile("" : "+v"(qlane));
#pragma unroll
        for (int ks = 0; ks < 8; ++ks) Qf[ks] = *(const bf16x8*)(qlane + ks * 32);
        f32x4 O[16];
#pragma unroll
        for (int dt = 0; dt < 16; ++dt) O[dt] = (f32x4){0.f, 0.f, 0.f, 0.f};
        float mrow = -1e30f, lrow = 0.f;
#pragma unroll 1
        for (int kb = 0; kb < 4; ++kb) {
            const bf16* klane = Km + ((size_t)b * 256 + kb * 64 + fr) * 1024 + hm * 256 + fq * 8; asm volatile("" : "+v"(klane));
            const bf16* vlane = VTm + ((((size_t)(b * 4 + hm)) * 64 + kb * 16 + fq) * 256 + fr) * 4; asm volatile("" : "+v"(vlane));
            f32x4 S[4];
#pragma unroll
            for (int kt = 0; kt < 4; ++kt) {
                S[kt] = (f32x4){0.f, 0.f, 0.f, 0.f};
                const bf16* kp = klane + kt * 16 * 1024; asm volatile("" : "+v"(kp));
#pragma unroll
                for (int ks = 0; ks < 8; ++ks) { const bf16x8 Kf = *(const bf16x8*)(kp + ks * 32); S[kt] = mfma16(Kf, Qf[ks], S[kt]); }
            }
            float mx = -1e30f;
#pragma unroll
            for (int kt = 0; kt < 4; ++kt)
#pragma unroll
                for (int r = 0; r < 4; ++r) mx = fmaxf(mx, S[kt][r]);
            mx = fmaxf(mx, __shfl_xor(mx, 16)); mx = fmaxf(mx, __shfl_xor(mx, 32));
            const float mnew = fmaxf(mrow, mx), alpha = __expf(mrow - mnew);
            float rs = 0.f;
#pragma unroll
            for (int kt = 0; kt < 4; ++kt)
#pragma unroll
                for (int r = 0; r < 4; ++r) { const float pz = __expf(S[kt][r] - mnew); S[kt][r] = pz; rs += pz; }
            rs += __shfl_xor(rs, 16); rs += __shfl_xor(rs, 32);
            lrow = lrow * alpha + rs; mrow = mnew;
#pragma unroll
            for (int dt = 0; dt < 16; ++dt) O[dt] = O[dt] * alpha;
#pragma unroll
            for (int a = 0; a < 2; ++a) {
                u32x4 pw; pw.x = pk2(S[2 * a][0], S[2 * a][1]); pw.y = pk2(S[2 * a][2], S[2 * a][3]); pw.z = pk2(S[2 * a + 1][0], S[2 * a + 1][1]); pw.w = pk2(S[2 * a + 1][2], S[2 * a + 1][3]);
                const bf16x8 Pf = __builtin_bit_cast(bf16x8, pw);
#pragma unroll
                for (int dt = 0; dt < 16; ++dt) {
                    const bf16* vp = vlane + a * 8192 + dt * 64;
                    const u32x2 lo = *(const u32x2*)vp, hi = *(const u32x2*)(vp + 4096);
                    const bf16x8 Vf = __builtin_bit_cast(bf16x8, (u32x4){lo.x, lo.y, hi.x, hi.y});
                    O[dt] = mfma16(Vf, Pf, O[dt]);
                }
            }
        }
        const float inv = 1.f / lrow;
        bf16* olane = oout + qrow * 1024 + hm * 256 + 4 * fq; asm volatile("" : "+v"(olane));
#pragma unroll
        for (int dt = 0; dt < 16; ++dt) { u32x2 o; o.x = pk2(O[dt][0] * inv, O[dt][1] * inv); o.y = pk2(O[dt][2] * inv, O[dt][3] * inv);
            *(u32x2*)(olane + dt * 16) = o; }
    }
}

__device__ __forceinline__ void pool_phase(const bf16* z, bf16* mout) {
    int tid = threadIdx.x; asm volatile("" : "+v"(tid)); const int lane = tid & 63, wave = __builtin_amdgcn_readfirstlane(tid >> 6); (void)lane; (void)wave;
    const int gtid = blockIdx.x * NTHR + tid, ngt = gridDim.x * NTHR;
    for (int idx = gtid; idx < T * 64; idx += ngt) {
        const int tok = idx >> 6, c8 = (idx & 63) * 8, g = c8 >> 7, w = 2 << g, s = tok & 4095;
        const int nwin = (s + 1 < w) ? s + 1 : w;
        float acc[8], u0[8];
#pragma unroll
        for (int i = 0; i < 8; ++i) acc[i] = 0.f;
        for (int j = 0; j < nwin; ++j) {
            const u32x4 v = *(const u32x4*)(z + (size_t)(tok - j) * ZW + c8);
            const float f[8] = {bflo(v.x), bfhi(v.x), bflo(v.y), bfhi(v.y), bflo(v.z), bfhi(v.z), bflo(v.w), bfhi(v.w)};
#pragma unroll
            for (int i = 0; i < 8; ++i) { acc[i] += f[i]; if (j == 0) u0[i] = f[i]; }
        }
        const float inv = 1.f / (float)nwin;
        u32x4 o; o.x = pk2(acc[0] * inv - u0[0], acc[1] * inv - u0[1]); o.y = pk2(acc[2] * inv - u0[2], acc[3] * inv - u0[3]);
        o.z = pk2(acc[4] * inv - u0[4], acc[5] * inv - u0[5]); o.w = pk2(acc[6] * inv - u0[6], acc[7] * inv - u0[7]);
        *(u32x4*)(mout + (size_t)tok * D + c8) = o;
    }
}

constexpr int HP = 136, VP = 72;
constexpr int L_QH = 0, L_QT = L_QH + 64 * HP * 2, L_KT = L_QT + 64 * HP * 2, L_VT = L_KT + 64 * HP * 2, L_P = L_VT + 128 * VP * 2, L_KTT = L_P + 64 * VP * 2,
              L_SEG = L_KTT + 128 * VP * 2, L_SSQ = L_SEG + 4 * 128 * 4, L_HEND = L_SSQ + 2 * 64 * 4;
static_assert(L_HEND <= 131072, "hgrn LDS map");
__device__ __forceinline__ void hgrn_gates(const bf16* z, size_t tok0, int hd, int d, int sg, float lb, float (&bl)[16], float (&kk)[16]) {
    float run = 0.f;
#pragma unroll
    for (int j = 0; j < 16; ++j) {
        float fz = bf1(z[(tok0 + sg * 16 + j) * ZW + 1024 + hd * 128 + d]);
        fz = fminf(fmaxf(fz, -60.f), 60.f);
        const float ls = (fz >= 0.f) ? -log1pf(expf(-fz)) : fz - log1pf(expf(fz));
        const float lf = ls + log1pf(lb * expf(-fz));
        kk[j] = (1.f - lb) / (1.f + expf(fz));
        run += lf; bl[j] = run;
    }
}
__device__ __forceinline__ float hgrn_lb(const float* lbl, int e, int ch) {
    if (e == 0) return 0.f;
    const float l0 = lbl[ch], l1 = lbl[512 + ch], mx = fmaxf(l0, l1), e0 = expf(l0 - mx), e1 = expf(l1 - mx);
    const float p0 = e0 / (e0 + e1), p1 = e1 / (e0 + e1);
    return fminf(fmaxf((p0 + p1) - p0, 0.f), 1.f);
}
__device__ __forceinline__ void hgrn_local_phase(LAS unsigned char* lds, const bf16* z, const float* lbl, int e, bf16* st, float* dec) {
    int tid = threadIdx.x; asm volatile("" : "+v"(tid)); const int lane = tid & 63, wave = __builtin_amdgcn_readfirstlane(tid >> 6); (void)lane; (void)wave;
    LAS bf16* kT = (LAS bf16*)(lds + L_KTT); LAS bf16* vT = (LAS bf16*)(lds + L_VT); LAS float* seg = (LAS float*)(lds + L_SEG);
    const int d = tid & 127, sg = tid >> 7, fr = lane & 15, fq = lane >> 4;
    for (int unit = blockIdx.x; unit < 2048; unit += gridDim.x) {
        const int n = unit & 63, bh = unit >> 6, hd = bh & 3, b = bh >> 2; const size_t tok0 = (size_t)b * 4096 + n * 64;
        const float lb = hgrn_lb(lbl, e, hd * 128 + d);
        float bl[16], kk[16];
        hgrn_gates(z, tok0, hd, d, sg, lb, bl, kk);
        __syncthreads();
        seg[sg * 128 + d] = bl[15];
        {
            unsigned wv[8];
#pragma unroll
            for (int j = 0; j < 8; ++j) { const unsigned a = z[(tok0 + sg * 16 + 2 * j) * ZW + 1536 + hd * 128 + d], c = z[(tok0 + sg * 16 + 2 * j + 1) * ZW + 1536 + hd * 128 + d]; wv[j] = a | (c << 16); }
            *(LAS u32x4*)(vT + d * VP + sg * 16) = (u32x4){wv[0], wv[1], wv[2], wv[3]}; *(LAS u32x4*)(vT + d * VP + sg * 16 + 8) = (u32x4){wv[4], wv[5], wv[6], wv[7]};
        }
        __syncthreads();
        float pre = 0.f, tot = 0.f;
#pragma unroll
        for (int s = 0; s < 4; ++s) { const float v = seg[s * 128 + d]; tot += v; if (s < sg) pre += v; }
        {
            unsigned wk[8];
#pragma unroll
            for (int j = 0; j < 8; ++j) { const float a = kk[2 * j] * expf(tot - (pre + bl[2 * j])), c = kk[2 * j + 1] * expf(tot - (pre + bl[2 * j + 1])); wk[j] = pk2(a, c); }
            *(LAS u32x4*)(kT + d * VP + sg * 16) = (u32x4){wk[0], wk[1], wk[2], wk[3]}; *(LAS u32x4*)(kT + d * VP + sg * 16 + 8) = (u32x4){wk[4], wk[5], wk[6], wk[7]};
        }
        if (sg == 0) dec[(size_t)unit * 128 + d] = expf(tot);
        __syncthreads();
        const int e0 = wave * 16;
        bf16x8 Vf[2];
#pragma unroll
        for (int ks = 0; ks < 2; ++ks) Vf[ks] = *(const LAS bf16x8*)(vT + (e0 + fr) * VP + ks * 32 + fq * 8);
#pragma unroll
        for (int dtile = 0; dtile < 8; ++dtile) {
            f32x4 acc = (f32x4){0.f, 0.f, 0.f, 0.f};
#pragma unroll
            for (int ks = 0; ks < 2; ++ks) { const bf16x8 Kf = *(const LAS bf16x8*)(kT + (dtile * 16 + fr) * VP + ks * 32 + fq * 8); acc = mfma16(Kf, Vf[ks], acc); }
            u32x2 o; o.x = pk2(acc[0], acc[1]); o.y = pk2(acc[2], acc[3]);
            *(u32x2*)(st + (size_t)unit * 16384 + (e0 + fr) * 128 + dtile * 16 + 4 * fq) = o;
        }
    }
}
__device__ __forceinline__ void hgrn_scan_phase(bf16* st, const float* dec) {
    int tid = threadIdx.x; asm volatile("" : "+v"(tid)); const int lane = tid & 63, wave = __builtin_amdgcn_readfirstlane(tid >> 6); (void)lane; (void)wave;
    const int gtid = blockIdx.x * NTHR + tid, ngt = gridDim.x * NTHR;
    for (int idx = gtid; idx < 32 * 4096; idx += ngt) {
        const int seq = idx >> 12, quad = idx & 4095, ee = quad >> 5, d4 = (quad & 31) * 4;
        float s0 = 0.f, s1 = 0.f, s2 = 0.f, s3 = 0.f;
#pragma unroll 8
        for (int n = 0; n < 64; ++n) {
            const int unit = seq * 64 + n;
            u32x2* p = (u32x2*)(st + (size_t)unit * 16384 + ee * 128 + d4);
            const u32x2 c = *p; const f32x4 dc = *(const f32x4*)(dec + (size_t)unit * 128 + d4);
            u32x2 o; o.x = pk2(s0, s1); o.y = pk2(s2, s3); *p = o;
            s0 = dc.x * s0 + bflo(c.x); s1 = dc.y * s1 + bfhi(c.x); s2 = dc.z * s2 + bflo(c.y); s3 = dc.w * s3 + bfhi(c.y);
        }
    }
}
__device__ __forceinline__ void hgrn_out_phase(LAS unsigned char* lds, const bf16* z, const float* lbl, int e, const bf16* st, const float* ogain, bf16* mout) {
    int tid = threadIdx.x; asm volatile("" : "+v"(tid)); const int lane = tid & 63, wave = __builtin_amdgcn_readfirstlane(tid >> 6); (void)lane; (void)wave;
    LAS bf16* qh = (LAS bf16*)(lds + L_QH); LAS bf16* qt = (LAS bf16*)(lds + L_QT); LAS bf16* kt = (LAS bf16*)(lds + L_KT);
    LAS bf16* vT = (LAS bf16*)(lds + L_VT); LAS bf16* P = (LAS bf16*)(lds + L_P); LAS float* seg = (LAS float*)(lds + L_SEG); LAS float* ssq = (LAS float*)(lds + L_SSQ);
    const int d = tid & 127, sg = tid >> 7, fr = lane & 15, fq = lane >> 4;
    for (int unit = blockIdx.x; unit < 2048; unit += gridDim.x) {
        const int n = unit & 63, bh = unit >> 6, hd = bh & 3, b = bh >> 2; const size_t tok0 = (size_t)b * 4096 + n * 64;
        const float lb = hgrn_lb(lbl, e, hd * 128 + d);
        float bl[16], kk[16];
        hgrn_gates(z, tok0, hd, d, sg, lb, bl, kk);
        __syncthreads();
        seg[sg * 128 + d] = bl[15];
        {
            unsigned wv[8];
#pragma unroll
            for (int j = 0; j < 8; ++j) { const unsigned a = z[(tok0 + sg * 16 + 2 * j) * ZW + 1536 + hd * 128 + d], c = z[(tok0 + sg * 16 + 2 * j + 1) * ZW + 1536 + hd * 128 + d]; wv[j] = a | (c << 16); }
            *(LAS u32x4*)(vT + d * VP + sg * 16) = (u32x4){wv[0], wv[1], wv[2], wv[3]}; *(LAS u32x4*)(vT + d * VP + sg * 16 + 8) = (u32x4){wv[4], wv[5], wv[6], wv[7]};
        }
        __syncthreads();
        float pre = 0.f;
#pragma unroll
        for (int s = 0; s < 4; ++s) { const float v = seg[s * 128 + d]; if (s < sg) pre += v; }
        const float ref = seg[d] + seg[128 + d];
#pragma unroll
        for (int j = 0; j < 16; ++j) {
            const int t = sg * 16 + j; const float bt = pre + bl[j];
            const float qv = bf1(z[(tok0 + t) * ZW + 512 + hd * 128 + d]);
            qh[t * HP + d] = (bf16)f2bf(qv * expf(bt));
            qt[t * HP + d] = (bf16)f2bf(qv * expf(bt - ref));
            kt[t * HP + d] = (bf16)f2bf(kk[j] * expf(ref - bt));
        }
        __syncthreads();
        {
            const int tt = wave >> 1;
#pragma unroll
            for (int i = 0; i < 2; ++i) {
                const int stl = (wave & 1) * 2 + i;
                f32x4 acc = (f32x4){0.f, 0.f, 0.f, 0.f};
                if (stl <= tt) {
#pragma unroll
                    for (int ks = 0; ks < 4; ++ks) { const bf16x8 Kf = *(const LAS bf16x8*)(kt + (stl * 16 + fr) * HP + ks * 32 + fq * 8), Qf = *(const LAS bf16x8*)(qt + (tt * 16 + fr) * HP + ks * 32 + fq * 8); acc = mfma16(Kf, Qf, acc); }
                }
                const int trow = tt * 16 + fr, s0 = stl * 16 + 4 * fq;
                float pv[4];
#pragma unroll
                for (int r = 0; r < 4; ++r) pv[r] = (stl <= tt && s0 + r <= trow) ? acc[r] : 0.f;
                u32x2 o; o.x = pk2(pv[0], pv[1]); o.y = pk2(pv[2], pv[3]);
                *(LAS u32x2*)(P + trow * VP + s0) = o;
            }
        }
        __syncthreads();
        const int tt = wave & 3, eh = wave >> 2, trow = tt * 16 + fr;
        f32x4 acc[4]; float ss = 0.f;
#pragma unroll
        for (int et = 0; et < 4; ++et) {
            const int e0 = eh * 64 + et * 16;
            acc[et] = (f32x4){0.f, 0.f, 0.f, 0.f};
#pragma unroll
            for (int ks = 0; ks < 4; ++ks) { const bf16x8 Sf = *(const bf16x8*)(st + (size_t)unit * 16384 + (e0 + fr) * 128 + ks * 32 + fq * 8), Qf = *(const LAS bf16x8*)(qh + trow * HP + ks * 32 + fq * 8); acc[et] = mfma16(Sf, Qf, acc[et]); }
#pragma unroll
            for (int ks = 0; ks < 2; ++ks) { const bf16x8 Vf = *(const LAS bf16x8*)(vT + (e0 + fr) * VP + ks * 32 + fq * 8), Pf = *(const LAS bf16x8*)(P + trow * VP + ks * 32 + fq * 8); acc[et] = mfma16(Vf, Pf, acc[et]); }
#pragma unroll
            for (int r = 0; r < 4; ++r) ss += acc[et][r] * acc[et][r];
        }
        ss += __shfl_xor(ss, 16); ss += __shfl_xor(ss, 32);
        if (fq == 0) ssq[eh * 64 + trow] = ss;
        __syncthreads();
        const float rstd = rsqrtf((ssq[trow] + ssq[64 + trow]) * (1.f / 128.f) + EPS);
#pragma unroll
        for (int et = 0; et < 4; ++et) {
            const int ec = eh * 64 + et * 16 + 4 * fq;
            const u32x2 gw2 = *(const u32x2*)(z + (tok0 + trow) * ZW + 2048 + hd * 128 + ec);
            const f32x4 og = *(const f32x4*)(ogain + ec);
            const float gv[4] = {bflo(gw2.x), bfhi(gw2.x), bflo(gw2.y), bfhi(gw2.y)};
            float ov[4];
#pragma unroll
            for (int r = 0; r < 4; ++r) { const float sl = gv[r] / (1.f + expf(-gv[r])); ov[r] = acc[et][r] * rstd * og[r] * sl; }
            u32x2 o; o.x = pk2(ov[0], ov[1]); o.y = pk2(ov[2], ov[3]);
            *(u32x2*)(mout + (tok0 + trow) * D + 512 + hd * 128 + ec) = o;
        }
    }
}

struct Args { const float* in[18]; float* out; unsigned char* ws; int ph_lo, ph_hi; };

__global__ void __launch_bounds__(NTHR, 2) trunk_fwd(Args args) {
    extern __shared__ __attribute__((aligned(16))) unsigned char lds_raw[];
    LAS unsigned char* lds = (LAS unsigned char*)lds_raw;
    cg::grid_group grid = cg::this_grid();
    const int tid = threadIdx.x, lane = tid & 63, wave = __builtin_amdgcn_readfirstlane(tid >> 6);
    const int G = gridDim.x, gw = blockIdx.x * 8 + wave, ngw = G * 8, gtid = blockIdx.x * NTHR + tid, ngt = G * NTHR;
    unsigned char* ws = args.ws;
    const float* x_in = args.in[0]; const float* mem = args.in[1]; const float* gains = args.in[2]; const float* memg = args.in[3];
    const float* w_in_ab = args.in[4]; const float* pool_w = args.in[5]; const float* pool_scale = args.in[6]; const float* lbl = args.in[7]; const float* rec_og = args.in[8];
    const float* w_out_ab = args.in[9]; const float* w_qkv = args.in[10]; const float* rel_bias = args.in[11]; const float* w_o_att = args.in[12];
    const float* w_mem_q = args.in[13]; const float* w_mem_kv = args.in[14]; const float* w_mem_o = args.in[15]; const float* w_ff1 = args.in[16]; const float* w_ff2 = args.in[17];
    float* xres = args.out;
    {
    bf16* Wb = (bf16*)(ws + WS_W); bf16* Hb = (bf16*)(ws + WS_H);
    bf16* Kmem = (bf16*)(ws + WS_MK); bf16* VTmem = (bf16*)(ws + WS_MV); bf16* memn = (bf16*)(ws + WS_MEMN);

    {
        LAS float* scr = (LAS float*)(lds + wave * 16384);
        int off = 0;
#define MAT(src, Ksrc, Nn, dst, ldt) { const int items = ((Ksrc) / 64) * ((Nn) / 32); const int first = ((gw - off) % ngw + ngw) % ngw; \
            for (int it = first; it < items; it += ngw) transpose_item((src), (Nn), (Nn) / 32, (dst), (ldt), scr, it, lane); off += items; }
        for (int l = 0; l < 4; ++l) {
            bf16* WL = Wb + (size_t)l * WL_STRIDE; const int eo = l >> 1;
            if ((l & 1) == 0) {
                MAT(w_in_ab + (size_t)eo * D * ZW, D, ZW, WL + WL_MIXIN, D)
                MAT(w_out_ab + (size_t)eo * D * D + (size_t)512 * D, 512, D, WL + WL_MIXOUT + 512, D)
            } else {
                MAT(w_qkv + (size_t)eo * D * 3072, D, 3072, WL + WL_MIXIN, D)
                MAT(w_o_att + (size_t)eo * D * D, D, D, WL + WL_MIXOUT, D)
            }
            MAT(w_mem_q + (size_t)l * D * D, D, D, WL + WL_MEMQ, D)
            MAT(w_mem_kv + (size_t)l * D * 2048, D, 2048, Wb + W_MEMKV + (size_t)l * 2048 * D, D)
            MAT(w_mem_o + (size_t)l * D * D, D, D, WL + WL_MEMO, D)
            MAT(w_ff1 + (size_t)l * D * FF, D, FF, WL + WL_FF1, D)
            MAT(w_ff2 + (size_t)l * FF * D, FF, D, WL + WL_FF2, FF)
        }
#undef MAT
        for (int idx = gtid; idx < 2 * 512 * 1024; idx += ngt) {
            const int nn = idx & 1023, kq = (idx >> 10) & 511, eo = idx >> 19, g = kq >> 7, c = kq & 127;
            const float* pw = pool_w + (((size_t)eo * 4 + g) * 128 + c) * 128; const float* ps = pool_scale + eo * 512 + g * 128;
            const float* wo = w_out_ab + (size_t)eo * D * D + (size_t)(g * 128) * D + nn;
            float a = 0.f;
            for (int dd = 0; dd < 128; ++dd) a += pw[dd] * ps[dd] * wo[(size_t)dd * D];
            Wb[(size_t)(2 * eo) * WL_STRIDE + WL_MIXOUT + (size_t)nn * D + kq] = (bf16)f2bf(a);
        }
        for (int r = gw; r < 2048; r += ngw) rms_row_to_bf16(mem + (size_t)r * D, memg, memn + (size_t)r * D, lane);
        for (int r = gw; r < T; r += ngw) rms_row_to_bf16(x_in + (size_t)r * D, gains, Hb + (size_t)r * D, lane);
        {
            float* par = (float*)(ws + WS_PAR);
            for (int i = gtid; i < PAR_N; i += ngt) par[i] = (i < PAR_LBL) ? gains[i] : (i < PAR_OG) ? lbl[i - PAR_LBL] : (i < PAR_RELB) ? rec_og[i - PAR_OG] : rel_bias[i - PAR_RELB];
        }
    }
    grid.sync();
    run_gemm<3>(lds, memn, Wb + W_MEMKV, 2048, 8192, D, Kmem, VTmem, nullptr, 0, 1.f);
    }

    for (int l = 0; l < 4; ++l) {
        unsigned char* wsl = args.ws; asm volatile("" : "+s"(wsl));
        bf16* Wb = (bf16*)(wsl + WS_W); bf16* Hb = (bf16*)(wsl + WS_H); bf16* R = (bf16*)(wsl + WS_R);
        bf16* Kmem = (bf16*)(wsl + WS_MK); bf16* VTmem = (bf16*)(wsl + WS_MV); float* decb = (float*)(wsl + WS_DEC);
        bf16* R0 = R; bf16* R64 = R + 32 * MiB; bf16* R128 = R + 64 * MiB; bf16* R192 = R + 96 * MiB;
        const float* par = (const float*)(wsl + WS_PAR);
        const bf16* WL = Wb + (size_t)l * WL_STRIDE; const float* gl = par + PAR_GAINS + (size_t)l * 6 * D; const int eo = l >> 1;
        const float* lblp = par + PAR_LBL; const float* ogp = par + PAR_OG + eo * 128; const float* relbp = par + PAR_RELB + (size_t)eo * 16 * 513;
        const float* xsrc = (l == 0) ? x_in : xres;
        if ((l & 1) == 0) {
            run_gemm<0>(lds, Hb, WL + WL_MIXIN, T, ZW, D, R0, nullptr, nullptr, ZW, 1.f);
            grid.sync();
            pool_phase(R0, R192);
            hgrn_local_phase(lds, R0, lblp, eo, Hb, decb);
            grid.sync();
            hgrn_scan_phase(Hb, decb);
            grid.sync();
            hgrn_out_phase(lds, R0, lblp, eo, Hb, ogp, R192);
            grid.sync();
        } else {
            run_gemm<2>(lds, Hb, WL + WL_MIXIN, T, 3072, D, R0, R64, R128, 1024, 0.125f);
            grid.sync();
            band_attn_phase(lds, R0, R64, R128, relbp, R192);
            grid.sync();
        }
        run_gemm<0>(lds, R192, WL + WL_MIXOUT, T, D, D, R0, nullptr, nullptr, D, 1.f);
        grid.sync();
        sweep_phase(R0, xsrc, xres, gl + 1 * D, gl + 2 * D, Hb);
        grid.sync();
        run_gemm<0>(lds, Hb, WL + WL_MEMQ, T, D, D, R64, nullptr, nullptr, D, 0.0625f);
        grid.sync();
        cross_attn_phase(R64, Kmem + (size_t)l * 2048 * D, VTmem + (size_t)l * 8 * 1024 * 256, R128);
        grid.sync();
        run_gemm<0>(lds, R128, WL + WL_MEMO, T, D, D, R0, nullptr, nullptr, D, 1.f);
        grid.sync();
        sweep_phase(R0, xres, xres, gl + 3 * D, gl + 4 * D, Hb);
        grid.sync();
        run_gemm<1>(lds, Hb, WL + WL_FF1, T, FF, D, R0, nullptr, nullptr, FF, 1.f);
        grid.sync();
        run_gemm<0>(lds, R0, WL + WL_FF2, T, D, FF, Hb, nullptr, nullptr, D, 1.f);
        grid.sync();
        sweep_phase(Hb, xres, xres, gl + 5 * D, (l < 3) ? gl + 6 * D : gl, (l < 3) ? Hb : nullptr);
        grid.sync();
    }
}

extern "C" void kernel_launch(void* const* d_in, const int* in_sizes, int n_in, void* d_out, int out_size, void* d_ws, size_t ws_size, hipStream_t stream) {
    static int grid = 0;
    if (grid == 0) {
        if (n_in != 18 || out_size != T * D || ws_size < WS_END) { fprintf(stderr, "kernel_launch: unexpected shapes (n_in %d out %d ws %zu)\n", n_in, out_size, ws_size); grid = -1; return; }
        int dev = 0, cus = 0, per_cu = 0;
        hipGetDevice(&dev); hipDeviceGetAttribute(&cus, hipDeviceAttributeMultiprocessorCount, dev);
        hipFuncSetAttribute((const void*)trunk_fwd, hipFuncAttributeMaxDynamicSharedMemorySize, LDS_BYTES);
        hipOccupancyMaxActiveBlocksPerMultiprocessor(&per_cu, (const void*)trunk_fwd, NTHR, LDS_BYTES);
        if (per_cu < 1) { fprintf(stderr, "kernel_launch: occupancy query says %d blocks/CU\n", per_cu); per_cu = 1; }
        (void)hipGetLastError();
        grid = cus;
    }
    if (grid < 0) return;
    Args a{};
    for (int i = 0; i < 18; ++i) a.in[i] = (const float*)d_in[i];
    a.out = (float*)d_out; a.ws = (unsigned char*)d_ws; a.ph_lo = 0; a.ph_hi = 1000;
    void* kargs[] = {&a};
    hipError_t e = hipLaunchCooperativeKernel((const void*)trunk_fwd, dim3(grid), dim3(NTHR), kargs, LDS_BYTES, stream);
    if (e != hipSuccess) fprintf(stderr, "cooperative launch failed: %s (grid %d)\n", hipGetErrorString(e), grid);
}
```

```cpp
#include <hip/hip_runtime.h>
#include <hip/hip_cooperative_groups.h>
#include <cstdio>
#include <cstdint>
namespace cg = cooperative_groups;
namespace pg8 {
#define PG8_LAS __attribute__((address_space(3)))
typedef unsigned short bf16_t;
typedef short bf16x8 __attribute__((ext_vector_type(8)));
typedef float f32x4 __attribute__((ext_vector_type(4)));
typedef unsigned u32x4 __attribute__((ext_vector_type(4)));
constexpr int BM = 256, BK = 64, HALF = 128, HTB = HALF * BK * 2  , STAGE_BYTES = 8 * HTB, NXCD = 8, WGM = 8;

__host__ __device__ __forceinline__ int lds_byte(int r, int c) { const int st = (r >> 4) * 2 + (c >> 5), rr = r & 15, cc = c & 31, ob = rr * 64 + cc * 2; return st * 1024 + (ob ^ (((ob >> 9) & 1) << 5)); }
__host__ __device__ __forceinline__ void stage_rc(int b, int& R, int& C) { const int st = b / 1024, sb = b % 1024, swz = sb ^ (((sb >> 9) & 1) << 5); R = (st >> 1) * 16 + swz / 64; C = (st & 1) * 32 + (swz % 64) / 2; }
__host__ __device__ __forceinline__ int perm32(int rho) { const int n = rho >> 4, i = rho & 15; return 8 * (i >> 2) + 4 * n + (i & 3); }

struct Unit { int pm, pn; };
struct Gemm { const bf16_t* A; const bf16_t* Bt; int M, N, K; };

struct StaticOrder {
    int nM, nN, nwg, G, c;
    __host__ __device__ void init(int M, int N, int G_, int c_) { nM = M / BM; nN = N / BM; nwg = nM * nN; G = G_; c = c_; }
    __host__ __device__ bool next(int i, Unit& u) const {
        const long L = (long)i * G + c; if (L >= nwg) return false;
        int wgid = (int)L; { const int q = nwg / NXCD, r = nwg % NXCD, xcd = wgid % NXCD, off = wgid / NXCD; wgid = (xcd < r ? xcd * (q + 1) : r * (q + 1) + (xcd - r) * q) + off; }
        const int nig = WGM * nN, gid = wgid / nig, fm = gid * WGM, gsz = (nM - fm) < WGM ? (nM - fm) : WGM;
        u.pm = fm + ((wgid % nig) % gsz); u.pn = (wgid % nig) / gsz; return true;
    }
    __device__ __forceinline__ void a_ready(const Unit&) const {}
    __device__ __forceinline__ void done(const Unit&) const {}
};
__device__ __forceinline__ unsigned cvt_pk_bf16(float lo, float hi) { unsigned r; asm volatile("v_cvt_pk_bf16_f32 %0, %1, %2" : "=v"(r) : "v"(lo), "v"(hi)); return r; }
typedef float f32x2 __attribute__((ext_vector_type(2)));
template <class Epi, class Sched, bool ALIGN_EPI = false, bool SP2 = false>
__device__ __forceinline__ void gemm_phase(PG8_LAS unsigned char* lds, const Gemm g, const Sched& S, const Epi& E) {
    int tid_l = threadIdx.x; asm volatile("" : "+v"(tid_l));
    const int tid = tid_l, wid = __builtin_amdgcn_readfirstlane(tid >> 6), lane = tid & 63, wr = wid >> 2, wc = wid & 3, fr = lane & 15, fq = lane >> 4;
    const int K = g.K, nt = K / BK;
    unsigned voffA[2], voffB[2];
#pragma unroll
    for (int i = 0; i < 2; ++i) { int R, C; stage_rc(tid * 16 + i * 8192, R, C); const int Rb = Epi::PERM ? ((R & ~31) + perm32(R & 31)) : R;
        voffA[i] = (unsigned)(R * K + C) * 2u; voffB[i] = (unsigned)(Rb * K + C) * 2u; }
    const size_t kstep = (size_t)(BK * 2);
    const size_t hstep = (size_t)HALF * K * 2;
    const size_t tstep = 2 * hstep;
    const unsigned ldsw = (unsigned)wid * 1024u;
    const int aoff = lds_byte(wr * 64 + fr, fq * 8), boff = lds_byte(wc * 32 + fr, fq * 8);
#define PG8_SA(b, h) (((b) * 2 + (h)) * HTB)
#define PG8_SB(b, h) ((4 + (b) * 2 + (h)) * HTB)
#define PG8_STAGE(bufoff, gbase, voff) do { _Pragma("unroll") for (int _i = 0; _i < 2; ++_i) \
        __builtin_amdgcn_global_load_lds((const unsigned*)((const char*)(gbase) + (voff)[_i]), (PG8_LAS unsigned*)(lds + (bufoff) + ldsw + _i * 8192), 16, 0, 0); } while (0)
#define PG8_LDA(dst, b, h) do { _Pragma("unroll") for (int m = 0; m < 4; ++m) _Pragma("unroll") for (int k = 0; k < 2; ++k) dst[m][k] = *(const PG8_LAS bf16x8*)(lds + PG8_SA(b, h) + aoff + m * 2048 + k * 1024); } while (0)
#define PG8_LDB(dst, b, h) do { _Pragma("unroll") for (int n = 0; n < 2; ++n) _Pragma("unroll") for (int k = 0; k < 2; ++k) dst[n][k] = *(const PG8_LAS bf16x8*)(lds + PG8_SB(b, h) + boff + n * 2048 + k * 1024); } while (0)
#define PG8_MMA(ai, bj, At, Bt) do { __builtin_amdgcn_s_setprio(1); _Pragma("unroll") for (int m = 0; m < 4; ++m) _Pragma("unroll") for (int n = 0; n < 2; ++n) _Pragma("unroll") for (int k = 0; k < 2; ++k) \
        acc[ai][bj][m][n] = __builtin_amdgcn_mfma_f32_16x16x32_bf16(Bt[n][k], At[m][k], acc[ai][bj][m][n], 0, 0, 0); __builtin_amdgcn_s_setprio(0); } while (0)
#define PG8_WAIT_V(n) asm volatile("s_waitcnt vmcnt(" #n ")" ::: "memory")
#define PG8_WAIT_L(n) asm volatile("s_waitcnt lgkmcnt(" #n ")" ::: "memory")
#define PG8_BAR __builtin_amdgcn_s_barrier()
#define PG8_SCHED __builtin_amdgcn_sched_barrier(0)
    Unit cur, nxt; int ui = 0;
    if (!S.next(0, cur)) return;
    f32x4 acc[2][2][4][2];
#pragma unroll
    for (int a = 0; a < 2; ++a)
#pragma unroll
        for (int b = 0; b < 2; ++b)
#pragma unroll
            for (int m = 0; m < 4; ++m)
#pragma unroll
                for (int n = 0; n < 2; ++n) acc[a][b][m][n] = (f32x4){0.f, 0.f, 0.f, 0.f};
    bf16x8 At[4][2], B0[2][2], B1[2][2];
    const char* cA = (const char*)g.A + (size_t)cur.pm * tstep; const char* cB = (const char*)g.Bt + (size_t)cur.pn * tstep;
    S.a_ready(cur);
    if constexpr (SP2) {
        PG8_STAGE(PG8_SB(0, 0), cB, voffB); PG8_STAGE(PG8_SB(0, 1), cB + hstep, voffB); PG8_STAGE(PG8_SA(0, 0), cA, voffA); PG8_STAGE(PG8_SA(0, 1), cA + hstep, voffA);
        if (wr == 1) PG8_BAR;
        PG8_WAIT_V(2); PG8_BAR;
        PG8_STAGE(PG8_SB(1, 0), cB + kstep, voffB); PG8_STAGE(PG8_SA(1, 0), cA + kstep, voffA); PG8_STAGE(PG8_SB(1, 1), cB + hstep + kstep, voffB);
        PG8_WAIT_V(6); PG8_BAR;
    } else {
        PG8_STAGE(PG8_SB(0, 0), cB, voffB); PG8_STAGE(PG8_SA(0, 0), cA, voffA); PG8_STAGE(PG8_SB(0, 1), cB + hstep, voffB); PG8_STAGE(PG8_SA(0, 1), cA + hstep, voffA);
        if (wr == 1) PG8_BAR;
        PG8_WAIT_V(4); PG8_BAR;
        PG8_STAGE(PG8_SB(1, 0), cB + kstep, voffB); PG8_STAGE(PG8_SA(1, 0), cA + kstep, voffA); PG8_STAGE(PG8_SB(1, 1), cB + hstep + kstep, voffB);
        PG8_WAIT_V(6); PG8_BAR;
    }
    for (;;) {
        const bool has_next = S.next(ui + 1, nxt);
        const char* nA = has_next ? (const char*)g.A + (size_t)nxt.pm * tstep : cA; const char* nB = has_next ? (const char*)g.Bt + (size_t)nxt.pn * tstep : cB;
        for (int t = 0; t < nt; t += 2) {
            const bool last = (t == nt - 2);
            const char* a1 = cA + (size_t)(t + 1) * kstep;
            const char* a2 = last ? nA : cA + (size_t)(t + 2) * kstep; const char* b2 = last ? nB : cB + (size_t)(t + 2) * kstep;
            const char* a3 = a2 + kstep; const char* b3 = b2 + kstep;
            if (last && has_next) S.a_ready(nxt);
            if constexpr (SP2) {
            PG8_LDB(B0, 0, 0); PG8_LDB(B1, 0, 1); PG8_SCHED; PG8_LDA(At, 0, 0); PG8_STAGE(PG8_SA(1, 1), a1 + hstep, voffA);
            PG8_WAIT_V(8); PG8_WAIT_L(0); PG8_BAR; PG8_MMA(0, 0, At, B0); PG8_MMA(0, 1, At, B1); PG8_BAR; PG8_SCHED;
            PG8_LDA(At, 0, 1); PG8_STAGE(PG8_SB(0, 0), b2, voffB); PG8_STAGE(PG8_SB(0, 1), b2 + hstep, voffB); PG8_STAGE(PG8_SA(0, 0), a2, voffA);
            PG8_WAIT_V(8); PG8_WAIT_L(0); PG8_BAR; PG8_MMA(1, 0, At, B0); PG8_MMA(1, 1, At, B1); PG8_BAR; PG8_SCHED;
            PG8_LDB(B0, 1, 0); PG8_LDB(B1, 1, 1); PG8_SCHED; PG8_LDA(At, 1, 0); PG8_STAGE(PG8_SA(0, 1), a2 + hstep, voffA);
            PG8_WAIT_V(8); PG8_WAIT_L(0); PG8_BAR; PG8_MMA(0, 0, At, B0); PG8_MMA(0, 1, At, B1); PG8_BAR; PG8_SCHED;
            PG8_LDA(At, 1, 1); PG8_STAGE(PG8_SB(1, 0), b3, voffB); PG8_STAGE(PG8_SB(1, 1), b3 + hstep, voffB); PG8_STAGE(PG8_SA(1, 0), a3, voffA);
            PG8_WAIT_V(8); PG8_WAIT_L(0); PG8_BAR; PG8_MMA(1, 0, At, B0); PG8_MMA(1, 1, At, B1); PG8_BAR; PG8_SCHED;
            } else {
            PG8_LDB(B0, 0, 0); PG8_SCHED; PG8_LDA(At, 0, 0); PG8_STAGE(PG8_SA(1, 1), a1 + hstep, voffA);
            PG8_WAIT_L(8); PG8_BAR; PG8_WAIT_L(0); PG8_MMA(0, 0, At, B0); PG8_BAR; PG8_SCHED;
            PG8_LDB(B1, 0, 1); PG8_STAGE(PG8_SB(0, 0), b2, voffB);
            PG8_BAR; PG8_WAIT_L(0); PG8_MMA(0, 1, At, B1); PG8_BAR;
            PG8_LDA(At, 0, 1); PG8_STAGE(PG8_SA(0, 0), a2, voffA);
            PG8_BAR; PG8_WAIT_L(0); PG8_MMA(1, 0, At, B0); PG8_BAR; PG8_SCHED;
            PG8_STAGE(PG8_SB(0, 1), b2 + hstep, voffB);
            PG8_WAIT_V(6); PG8_BAR; PG8_MMA(1, 1, At, B1); PG8_BAR;
            PG8_LDB(B0, 1, 0); PG8_SCHED; PG8_LDA(At, 1, 0); PG8_STAGE(PG8_SA(0, 1), a2 + hstep, voffA);
            PG8_WAIT_L(8); PG8_BAR; PG8_WAIT_L(0); PG8_MMA(0, 0, At, B0); PG8_BAR; PG8_SCHED;
            PG8_LDB(B1, 1, 1); PG8_STAGE(PG8_SB(1, 0), b3, voffB);
            PG8_BAR; PG8_WAIT_L(0); PG8_MMA(0, 1, At, B1); PG8_BAR;
            PG8_LDA(At, 1, 1); PG8_STAGE(PG8_SA(1, 0), a3, voffA);
            PG8_BAR; PG8_WAIT_L(0); PG8_MMA(1, 0, At, B0); PG8_BAR; PG8_SCHED;
            PG8_STAGE(PG8_SB(1, 1), b3 + hstep, voffB);
            PG8_WAIT_V(6); PG8_BAR; PG8_MMA(1, 1, At, B1); PG8_BAR;
            }
        }
        if constexpr (ALIGN_EPI) { if (wr == 0) PG8_BAR; }
        if constexpr (!Epi::AFTER_DRAIN) { E(acc, cur, wr, wc, fr, fq); S.done(cur); }
        if (!has_next) break;
#pragma unroll
        for (int a = 0; a < 2; ++a)
#pragma unroll
            for (int b = 0; b < 2; ++b)
#pragma unroll
                for (int m = 0; m < 4; ++m)
#pragma unroll
                    for (int n = 0; n < 2; ++n) acc[a][b][m][n] = (f32x4){0.f, 0.f, 0.f, 0.f};
        cur = nxt; cA = nA; cB = nB; ++ui;
        if constexpr (ALIGN_EPI) { if (wr == 1) PG8_BAR; }
    }
    PG8_WAIT_V(0);
    if constexpr (!ALIGN_EPI) { if (wr == 0) PG8_BAR; }
    PG8_BAR;
    if constexpr (Epi::AFTER_DRAIN) { E.fused(acc, cur, wr, wc, fr, fq, lds, wid, lane); S.done(cur); }
#undef PG8_SA
#undef PG8_SB
#undef PG8_STAGE
#undef PG8_LDA
#undef PG8_LDB
#undef PG8_MMA
#undef PG8_WAIT_V
#undef PG8_WAIT_L
#undef PG8_BAR
#undef PG8_SCHED
}
}
#ifndef PG8_SP2
#define PG8_SP2 true
#endif
#ifndef PG8_ALIGN
#define PG8_ALIGN true
#endif
constexpr int D = 1024, BATCH = 8, SEQ = 4096, T = BATCH * SEQ, FF = 4096, ZW = 2560;
constexpr float EPS = 1e-6f;
constexpr int NTHR = 512;
constexpr int LDS_BYTES = 147456;
constexpr size_t MiB = 1u << 20;
constexpr size_t WS_W = 0;
constexpr size_t WL_STRIDE = 14 * MiB;
constexpr size_t WL_MIXIN = 0, WL_MIXOUT = 3 * MiB, WL_MEMQ = 4 * MiB, WL_MEMO = 5 * MiB, WL_FF1 = 6 * MiB, WL_FF2 = 10 * MiB;
constexpr size_t W_MEMKV = 56 * MiB;
constexpr size_t WS_H = 128 * MiB;
constexpr size_t WS_R = 192 * MiB;
constexpr size_t WS_MK = 448 * MiB;
constexpr size_t WS_MV = 464 * MiB;
constexpr size_t WS_MEMN = 480 * MiB;
constexpr size_t WS_DEC = 484 * MiB;
constexpr size_t WS_PAR = 485 * MiB;
constexpr int PAR_GAINS = 0, PAR_LBL = 24576, PAR_OG = 25600, PAR_RELB = 25856, PAR_N = 25856 + 2 * 16 * 513;
constexpr size_t WS_END = 486 * MiB;

#define LAS __attribute__((address_space(3)))
typedef unsigned short bf16;
typedef short bf16x8 __attribute__((ext_vector_type(8)));
typedef float f32x4 __attribute__((ext_vector_type(4)));
typedef unsigned u32x4 __attribute__((ext_vector_type(4)));
typedef unsigned u32x2 __attribute__((ext_vector_type(2)));
#define LDS_WAIT() asm volatile("s_waitcnt lgkmcnt(0)" ::: "memory")

__device__ __forceinline__ unsigned f2bf(float f) { unsigned u = __float_as_uint(f); return (u + 0x7fffu + ((u >> 16) & 1u)) >> 16; }
__device__ __forceinline__ unsigned pk2(float lo, float hi) { return f2bf(lo) | (f2bf(hi) << 16); }
__device__ __forceinline__ float bflo(unsigned w) { return __uint_as_float(w << 16); }
__device__ __forceinline__ float bfhi(unsigned w) { return __uint_as_float(w & 0xffff0000u); }
__device__ __forceinline__ float bf1(bf16 b) { return __uint_as_float(((unsigned)b) << 16); }
__device__ __forceinline__ f32x4 mfma16(bf16x8 a, bf16x8 b, f32x4 c) { return __builtin_amdgcn_mfma_f32_16x16x32_bf16(a, b, c, 0, 0, 0); }
__device__ __forceinline__ float wave_sum(float v) {
#pragma unroll
    for (int o = 1; o < 64; o <<= 1) v += __shfl_xor(v, o);
    return v;
}

template <int MODE> struct Epi {
    static constexpr bool PERM = true, AFTER_DRAIN = false;
    bf16* O0; bf16* O1; bf16* O2; int ldc; float scale;
    __device__ __forceinline__ void operator()(const pg8::f32x4 (&acc)[2][2][4][2], const pg8::Unit& u, int wr, int wc, int fr, int fq) const {
        const int row0 = u.pm * 256 + wr * 64 + fr, colb = u.pn * 256 + wc * 32 + 8 * fq;
#pragma unroll
        for (int ai = 0; ai < 2; ++ai)
#pragma unroll
            for (int m = 0; m < 4; ++m) {
                const int row = row0 + ai * 128 + m * 16;
#pragma unroll
                for (int bj = 0; bj < 2; ++bj) {
                    const int col = colb + bj * 128;
                    pg8::f32x4 v0 = acc[ai][bj][m][0], v1 = acc[ai][bj][m][1];
                    if (MODE == 0) { v0 = v0 * scale; v1 = v1 * scale; }
                    if (MODE == 1) {
#pragma unroll
                        for (int j = 0; j < 4; ++j) { const float a = fmaxf(v0[j], 0.f), b = fmaxf(v1[j], 0.f); v0[j] = a * a; v1[j] = b * b; }
                    }
                    if (MODE == 2 && (u.pn >> 2) == 0) { v0 = v0 * scale; v1 = v1 * scale; }
                    u32x4 w; w.x = pk2(v0[0], v0[1]); w.y = pk2(v0[2], v0[3]); w.z = pk2(v1[0], v1[1]); w.w = pk2(v1[2], v1[3]);
                    if (MODE == 0 || MODE == 1) { *(u32x4*)(O0 + (size_t)row * ldc + col) = w; }
                    if (MODE == 2) {
                        const int t = u.pn >> 2, c = col - t * 1024;
                        if (t == 0) *(u32x4*)(O0 + (size_t)row * 1024 + c) = w;
                        else if (t == 1) *(u32x4*)(O1 + (size_t)row * 1024 + c) = w;
                        else {
                            const int sq = row & 4095, j6 = sq & 63;
                            bf16* vp = O2 + (((size_t)((row >> 12) * 16 + (c >> 6))) * 64 + (sq >> 6)) * 4096 + ((((j6 >> 5) * 4 + ((j6 >> 2) & 3)) * 64 + (c & 63)) * 8 + ((j6 >> 4) & 1) * 4 + (j6 & 3));
                            vp[0] = (bf16)(w.x & 0xffff); vp[8] = (bf16)(w.x >> 16); vp[16] = (bf16)(w.y & 0xffff); vp[24] = (bf16)(w.y >> 16);
                            vp[32] = (bf16)(w.z & 0xffff); vp[40] = (bf16)(w.z >> 16); vp[48] = (bf16)(w.w & 0xffff); vp[56] = (bf16)(w.w >> 16);
                        }
                    }
                    if (MODE == 3) {
                        const int l = col >> 11, cc = col & 2047;
                        if (cc < 1024) *(u32x4*)(O0 + ((size_t)l * 2048 + row) * 1024 + cc) = w;
                        else {
                            const int mq = row & 255, cv = cc - 1024;
                            bf16* vp = O1 + (((size_t)l * 8 + (row >> 8)) * 4 + (cv >> 8)) * 65536 + ((((mq >> 5) * 4 + ((mq >> 2) & 3)) * 256 + (cv & 255)) * 8 + ((mq >> 4) & 1) * 4 + (mq & 3));
                            vp[0] = (bf16)(w.x & 0xffff); vp[8] = (bf16)(w.x >> 16); vp[16] = (bf16)(w.y & 0xffff); vp[24] = (bf16)(w.y >> 16);
                            vp[32] = (bf16)(w.z & 0xffff); vp[40] = (bf16)(w.z >> 16); vp[48] = (bf16)(w.w & 0xffff); vp[56] = (bf16)(w.w >> 16);
                        }
                    }
                }
            }
    }
};

template <int MODE>
__device__ __forceinline__ void run_gemm(LAS unsigned char* lds, const bf16* A, const bf16* Bt, int M, int N, int K, bf16* O0, bf16* O1, bf16* O2, int ldc, float scale) {
    const int gsz = (int)gridDim.x, cid = (int)blockIdx.x;
    pg8::Gemm g{A, Bt, M, N, K}; pg8::StaticOrder S; S.init(M, N, gsz, cid);
    Epi<MODE> E{O0, O1, O2, ldc, scale};
    pg8::gemm_phase<Epi<MODE>, pg8::StaticOrder, PG8_ALIGN, PG8_SP2>(lds, g, S, E);
}

__device__ __forceinline__ void transpose_item(const float* W, int ldw, int nblk, bf16* WT, int ldt, LAS float* scr, int item, int lane) {
    const int kb = item / nblk, nb = item % nblk, k0 = 64 * kb, n0 = 32 * nb;
#pragma unroll 8
    for (int i = 0; i < 32; ++i) { const int kk = 2 * i + (lane >> 5); scr[kk * 33 + (lane & 31)] = W[(size_t)(k0 + kk) * ldw + n0 + (lane & 31)]; }
    LDS_WAIT(); asm volatile("" ::: "memory");
    const int c = lane & 7;
#pragma unroll
    for (int j = 0; j < 4; ++j) { const int n = (lane >> 3) + 8 * j; const LAS float* s = scr + (8 * c) * 33 + n;
        u32x4 o; o.x = pk2(s[0 * 33], s[1 * 33]); o.y = pk2(s[2 * 33], s[3 * 33]); o.z = pk2(s[4 * 33], s[5 * 33]); o.w = pk2(s[6 * 33], s[7 * 33]);
        *(u32x4*)(WT + (size_t)(n0 + n) * ldt + k0 + 8 * c) = o; }
    LDS_WAIT(); asm volatile("" ::: "memory");
}
__device__ __forceinline__ void rms_row_to_bf16(const float* xrow, const float* gain, bf16* orow, int lane) {
    float ss = 0.f; f32x4 v[4];
#pragma unroll
    for (int j = 0; j < 4; ++j) { v[j] = *(const f32x4*)(xrow + j * 256 + lane * 4); ss += (v[j].x * v[j].x + v[j].y * v[j].y) + (v[j].z * v[j].z + v[j].w * v[j].w); }
    const float r = rsqrtf(wave_sum(ss) * (1.f / D) + EPS);
#pragma unroll
    for (int j = 0; j < 4; ++j) { const f32x4 g = *(const f32x4*)(gain + j * 256 + lane * 4);
        u32x2 o; o.x = pk2(v[j].x * r * g.x, v[j].y * r * g.y); o.y = pk2(v[j].z * r * g.z, v[j].w * r * g.w);
        *(u32x2*)(orow + j * 256 + lane * 4) = o; }
}

__device__ __forceinline__ void sweep_phase(const bf16* y, const float* xin, float* xout, const float* ga, const float* gb, bf16* hout) {
    int tid = threadIdx.x; asm volatile("" : "+v"(tid)); const int lane = tid & 63, wave = __builtin_amdgcn_readfirstlane(tid >> 6); (void)lane; (void)wave;
    const int gw = blockIdx.x * 8 + wave, ngw = gridDim.x * 8;
    for (int row = gw; row < T; row += ngw) {
        const bf16* yr = y + (size_t)row * D; const float* xr = xin + (size_t)row * D; float* xo = xout + (size_t)row * D;
        float yv[2][8], xv[2][8]; float ss = 0.f;
#pragma unroll
        for (int j = 0; j < 2; ++j) {
            const u32x4 w = *(const u32x4*)(yr + j * 512 + lane * 8);
            yv[j][0] = bflo(w.x); yv[j][1] = bfhi(w.x); yv[j][2] = bflo(w.y); yv[j][3] = bfhi(w.y); yv[j][4] = bflo(w.z); yv[j][5] = bfhi(w.z); yv[j][6] = bflo(w.w); yv[j][7] = bfhi(w.w);
            const f32x4 a = *(const f32x4*)(xr + j * 512 + lane * 8), b = *(const f32x4*)(xr + j * 512 + lane * 8 + 4);
            xv[j][0] = a.x; xv[j][1] = a.y; xv[j][2] = a.z; xv[j][3] = a.w; xv[j][4] = b.x; xv[j][5] = b.y; xv[j][6] = b.z; xv[j][7] = b.w;
#pragma unroll
            for (int i = 0; i < 8; ++i) ss += yv[j][i] * yv[j][i];
        }
        const float r1 = rsqrtf(wave_sum(ss) * (1.f / D) + EPS);
        float s2 = 0.f;
#pragma unroll
        for (int j = 0; j < 2; ++j) {
            const f32x4 g0 = *(const f32x4*)(ga + j * 512 + lane * 8), g1 = *(const f32x4*)(ga + j * 512 + lane * 8 + 4);
            const float gg[8] = {g0.x, g0.y, g0.z, g0.w, g1.x, g1.y, g1.z, g1.w};
#pragma unroll
            for (int i = 0; i < 8; ++i) { xv[j][i] = xv[j][i] + yv[j][i] * r1 * gg[i]; s2 += xv[j][i] * xv[j][i]; }
            *(f32x4*)(xo + j * 512 + lane * 8) = (f32x4){xv[j][0], xv[j][1], xv[j][2], xv[j][3]};
            *(f32x4*)(xo + j * 512 + lane * 8 + 4) = (f32x4){xv[j][4], xv[j][5], xv[j][6], xv[j][7]};
        }
        if (hout) {
            const float r2 = rsqrtf(wave_sum(s2) * (1.f / D) + EPS);
#pragma unroll
            for (int j = 0; j < 2; ++j) {
                const f32x4 g0 = *(const f32x4*)(gb + j * 512 + lane * 8), g1 = *(const f32x4*)(gb + j * 512 + lane * 8 + 4);
                u32x4 o; o.x = pk2(xv[j][0] * r2 * g0.x, xv[j][1] * r2 * g0.y); o.y = pk2(xv[j][2] * r2 * g0.z, xv[j][3] * r2 * g0.w);
                o.z = pk2(xv[j][4] * r2 * g1.x, xv[j][5] * r2 * g1.y); o.w = pk2(xv[j][6] * r2 * g1.z, xv[j][7] * r2 * g1.w);
                *(u32x4*)(hout + (size_t)row * D + j * 512 + lane * 8) = o;
            }
        }
    }
}

constexpr int BK_PITCH = 160, B_KB = 64 * BK_PITCH, B_VB = 8192, B_BIAS = 2304, B_BUF = B_KB + B_VB;
__device__ __forceinline__ void band_attn_phase(LAS unsigned char* lds, const bf16* q, const bf16* k, const bf16* v8, const float* relb, bf16* mout) {
    int tid = threadIdx.x; asm volatile("" : "+v"(tid)); const int lane = tid & 63, wave = __builtin_amdgcn_readfirstlane(tid >> 6);
    LAS float* biasL = (LAS float*)lds;
    const int fr = lane & 15, fq = lane >> 4;
    const int kr = tid >> 3, kcc = tid & 7;
    for (int qd = blockIdx.x; qd < 2048; qd += gridDim.x) {
        const int bh = qd >> 4, h = bh & 15, b = bh >> 4, n0 = (qd & 15) * 4, n = n0 + (wave >> 1);
        const int kc_lo = (n0 >= 8) ? n0 - 8 : 0, kc_hi = n0 + 3;
        __syncthreads();
        for (int i = tid; i < 513; i += NTHR) biasL[i] = relb[h * 513 + i];
        const bf16* ksrc = k + ((size_t)b * 4096 + kr) * 1024 + h * 64 + kcc * 8;
        const bf16* vsrc = v8 + ((size_t)(b * 16 + h) * 64) * 4096 + tid * 8;
        u32x4 kreg = *(const u32x4*)(ksrc + (size_t)kc_lo * 65536), vreg = *(const u32x4*)(vsrc + (size_t)kc_lo * 4096);
        const int t0 = (wave & 1) * 32;
        bf16x8 Qf[2][2];
#pragma unroll
        for (int g = 0; g < 2; ++g) {
            const bf16* qlane = q + ((size_t)b * 4096 + n * 64 + t0 + g * 16 + fr) * 1024 + h * 64 + fq * 8; asm volatile("" : "+v"(qlane));
#pragma unroll
            for (int ks = 0; ks < 2; ++ks) Qf[g][ks] = *(const bf16x8*)(qlane + ks * 32);
        }
        f32x4 O[2][4]; float mrow[2], lrow[2];
#pragma unroll
        for (int g = 0; g < 2; ++g) { mrow[g] = -1e30f; lrow[g] = 0.f;
#pragma unroll
            for (int dt = 0; dt < 4; ++dt) O[g][dt] = (f32x4){0.f, 0.f, 0.f, 0.f}; }
        *(LAS u32x4*)(lds + B_BIAS + kr * BK_PITCH + kcc * 16) = kreg; *(LAS u32x4*)(lds + B_BIAS + B_KB + tid * 16) = vreg;
        __syncthreads();
#pragma unroll 1
        for (int kc = kc_lo; kc <= kc_hi; ++kc) {
            const int cur = (kc - kc_lo) & 1;
            if (kc < kc_hi) { kreg = *(const u32x4*)(ksrc + (size_t)(kc + 1) * 65536); vreg = *(const u32x4*)(vsrc + (size_t)(kc + 1) * 4096); }
            if (kc >= n - 8 && kc <= n) {
                LAS unsigned char* Kb = lds + B_BIAS + cur * B_BUF; LAS unsigned char* Vb = Kb + B_KB;
                const int jb = kc - (n - 8);
                f32x4 S[2][4];
#pragma unroll
                for (int kt = 0; kt < 4; ++kt) {
#pragma unroll
                    for (int g = 0; g < 2; ++g) S[g][kt] = (f32x4){0.f, 0.f, 0.f, 0.f};
#pragma unroll
                    for (int ks = 0; ks < 2; ++ks) {
                        const bf16x8 Kf = *(const LAS bf16x8*)(Kb + (kt * 16 + fr) * BK_PITCH + ks * 64 + fq * 16);
#pragma unroll
                        for (int g = 0; g < 2; ++g) S[g][kt] = mfma16(Kf, Qf[g][ks], S[g][kt]);
                    }
                }
#pragma unroll
                for (int g = 0; g < 2; ++g) {
                    float mx = -1e30f;
#pragma unroll
                    for (int kt = 0; kt < 4; ++kt)
#pragma unroll
                        for (int r = 0; r < 4; ++r) {
                            int rel = (8 - jb) * 64 + (t0 + g * 16 + fr) - (kt * 16 + 4 * fq + r);
                            rel = rel < -256 ? -256 : (rel > 256 ? 256 : rel);
                            const float s = S[g][kt][r] + biasL[rel + 256]; S[g][kt][r] = s; mx = fmaxf(mx, s);
                        }
                    mx = fmaxf(mx, __shfl_xor(mx, 16)); mx = fmaxf(mx, __shfl_xor(mx, 32));
                    const float mnew = fmaxf(mrow[g], mx), alpha = __expf(mrow[g] - mnew);
                    float rs = 0.f;
#pragma unroll
                    for (int kt = 0; kt < 4; ++kt)
#pragma unroll
                        for (int r = 0; r < 4; ++r) { const float pz = __expf(S[g][kt][r] - mnew); S[g][kt][r] = pz; rs += pz; }
                    rs += __shfl_xor(rs, 16); rs += __shfl_xor(rs, 32);
                    lrow[g] = lrow[g] * alpha + rs; mrow[g] = mnew;
#pragma unroll
                    for (int dt = 0; dt < 4; ++dt) O[g][dt] = O[g][dt] * alpha;
                }
#pragma unroll
                for (int a = 0; a < 2; ++a) {
                    bf16x8 Pf[2];
#pragma unroll
                    for (int g = 0; g < 2; ++g) { u32x4 pw; pw.x = pk2(S[g][2 * a][0], S[g][2 * a][1]); pw.y = pk2(S[g][2 * a][2], S[g][2 * a][3]); pw.z = pk2(S[g][2 * a + 1][0], S[g][2 * a + 1][1]); pw.w = pk2(S[g][2 * a + 1][2], S[g][2 * a + 1][3]);
                        Pf[g] = __builtin_bit_cast(bf16x8, pw); }
#pragma unroll
                    for (int dt = 0; dt < 4; ++dt) {
                        const bf16x8 Vf = *(const LAS bf16x8*)(Vb + ((a * 4 + fq) * 64 + dt * 16 + fr) * 16);
#pragma unroll
                        for (int g = 0; g < 2; ++g) O[g][dt] = mfma16(Vf, Pf[g], O[g][dt]);
                    }
                }
            }
            if (kc < kc_hi) { LAS unsigned char* Kn = lds + B_BIAS + (cur ^ 1) * B_BUF; *(LAS u32x4*)(Kn + kr * BK_PITCH + kcc * 16) = kreg; *(LAS u32x4*)(Kn + B_KB + tid * 16) = vreg; }
            __syncthreads();
        }
#pragma unroll
        for (int g = 0; g < 2; ++g) {
            const float inv = 1.f / lrow[g];
            bf16* olane = mout + ((size_t)b * 4096 + n * 64 + t0 + g * 16 + fr) * 1024 + h * 64 + 4 * fq; asm volatile("" : "+v"(olane));
#pragma unroll
            for (int dt = 0; dt < 4; ++dt) { u32x2 o; o.x = pk2(O[g][dt][0] * inv, O[g][dt][1] * inv); o.y = pk2(O[g][dt][2] * inv, O[g][dt][3] * inv); *(u32x2*)(olane + dt * 16) = o; }
        }
    }
}

constexpr int CK_PITCH = 544, C_KB = 64 * CK_PITCH, C_VB = 32768, C_BUF = C_KB + C_VB;
static_assert(2 * C_BUF <= 140000, "cross-attention LDS ring");
__device__ __forceinline__ void cross_attn_phase(LAS unsigned char* lds, const bf16* qm, const bf16* Km, const bf16* Vm8, bf16* oout) {
    int tid = threadIdx.x; asm volatile("" : "+v"(tid)); const int lane = tid & 63, wave = __builtin_amdgcn_readfirstlane(tid >> 6);
    const int fr = lane & 15, fq = lane >> 4;
    const int kr = tid >> 5, kcc = tid & 31;
    for (int bu = blockIdx.x; bu < 1024; bu += gridDim.x) {
        const int bhm = bu >> 5, hm = bhm & 3, b = bhm >> 2;
        const size_t qrow = (size_t)b * 4096 + (bu & 31) * 128 + wave * 16 + fr;
        const bf16* ksrc = Km + ((size_t)b * 256 + kr) * 1024 + hm * 256 + kcc * 8;
        const bf16* vsrc = Vm8 + (size_t)(b * 4 + hm) * 65536 + tid * 8;
        u32x4 kreg[4], vreg[4];
#pragma unroll
        for (int i = 0; i < 4; ++i) { kreg[i] = *(const u32x4*)(ksrc + (size_t)(16 * i) * 1024); vreg[i] = *(const u32x4*)(vsrc + i * 4096); }
        bf16x8 Qf[8];
        const bf16* qlane = qm + qrow * 1024 + hm * 256 + fq * 8; asm volatile("" : "+v"(qlane));
#pragma unroll
        for (int ks = 0; ks < 8; ++ks) Qf[ks] = *(const bf16x8*)(qlane + ks * 32);
        f32x4 O[16];
#pragma unroll
        for (int dt = 0; dt < 16; ++dt) O[dt] = (f32x4){0.f, 0.f, 0.f, 0.f};
        float mrow = -1e30f, lrow = 0.f;
        __syncthreads();
#pragma unroll
        for (int i = 0; i < 4; ++i) { *(LAS u32x4*)(lds + (kr + 16 * i) * CK_PITCH + kcc * 16) = kreg[i]; *(LAS u32x4*)(lds + C_KB + (tid + 512 * i) * 16) = vreg[i]; }
        __syncthreads();
#pragma unroll 1
        for (int kb = 0; kb < 4; ++kb) {
            const int cur = kb & 1;
            if (kb < 3) {
#pragma unroll
                for (int i = 0; i < 4; ++i) { kreg[i] = *(const u32x4*)(ksrc + (size_t)((kb + 1) * 64 + 16 * i) * 1024); vreg[i] = *(const u32x4*)(vsrc + (kb + 1) * 16384 + i * 4096); }
            }
            LAS unsigned char* Kb = lds + cur * C_BUF; LAS unsigned char* Vb = Kb + C_KB;
            f32x4 S[4];
#pragma unroll
            for (int kt = 0; kt < 4; ++kt) {
                S[kt] = (f32x4){0.f, 0.f, 0.f, 0.f};
#pragma unroll
                for (int ks = 0; ks < 8; ++ks) { const bf16x8 Kf = *(const LAS bf16x8*)(Kb + (kt * 16 + fr) * CK_PITCH + ks * 64 + fq * 16); S[kt] = mfma16(Kf, Qf[ks], S[kt]); }
            }
            float mx = -1e30f;
#pragma unroll
            for (int kt = 0; kt < 4; ++kt)
#pragma unroll
                for (int r = 0; r < 4; ++r) mx = fmaxf(mx, S[kt][r]);
            mx = fmaxf(mx, __shfl_xor(mx, 16)); mx = fmaxf(mx, __shfl_xor(mx, 32));
            const float mnew = fmaxf(mrow, mx), alpha = __expf(mrow - mnew);
            float rs = 0.f;
#pragma unroll
            for (int kt = 0; kt < 4; ++kt)
#pragma unroll
                for (int r = 0; r < 4; ++r) { const float pz = __expf(S[kt][r] - mnew); S[kt][r] = pz; rs += pz; }
            rs += __shfl_xor(rs, 16); rs += __shfl_xor(rs, 32);
            lrow = lrow * alpha + rs; mrow = mnew;
#pragma unroll
            for (int dt = 0; dt < 16; ++dt) O[dt] = O[dt] * alpha;
#pragma unroll
            for (int a = 0; a < 2; ++a) {
                u32x4 pw; pw.x = pk2(S[2 * a][0], S[2 * a][1]); pw.y = pk2(S[2 * a][2], S[2 * a][3]); pw.z = pk2(S[2 * a + 1][0], S[2 * a + 1][1]); pw.w = pk2(S[2 * a + 1][2], S[2 * a + 1][3]);
                const bf16x8 Pf = __builtin_bit_cast(bf16x8, pw);
#pragma unroll
                for (int dt = 0; dt < 16; ++dt) { const bf16x8 Vf = *(const LAS bf16x8*)(Vb + ((a * 4 + fq) * 256 + dt * 16 + fr) * 16); O[dt] = mfma16(Vf, Pf, O[dt]); }
            }
            if (kb < 3) {
                LAS unsigned char* Kn = lds + (cur ^ 1) * C_BUF;
#pragma unroll
                for (int i = 0; i < 4; ++i) { *(LAS u32x4*)(Kn + (kr + 16 * i) * CK_PITCH + kcc * 16) = kreg[i]; *(LAS u32x4*)(Kn + C_KB + (tid + 512 * i) * 16) = vreg[i]; }
            }
            __syncthreads();
        }
        const float inv = 1.f / lrow;
        bf16* olane = oout + qrow * 1024 + hm * 256 + 4 * fq; asm volatile("" : "+v"(olane));
#pragma unroll
        for (int dt = 0; dt < 16; ++dt) { u32x2 o; o.x = pk2(O[dt][0] * inv, O[dt][1] * inv); o.y = pk2(O[dt][2] * inv, O[dt][3] * inv);
            *(u32x2*)(olane + dt * 16) = o; }
    }
}

__device__ __forceinline__ void pool_phase(const bf16* z, bf16* mout) {
    int tid = threadIdx.x; asm volatile("" : "+v"(tid)); const int lane = tid & 63, wave = __builtin_amdgcn_readfirstlane(tid >> 6); (void)lane; (void)wave;
    const int gtid = blockIdx.x * NTHR + tid, ngt = gridDim.x * NTHR;
    for (int idx = gtid; idx < T * 64; idx += ngt) {
        const int tok = idx >> 6, c8 = (idx & 63) * 8, g = c8 >> 7, w = 2 << g, s = tok & 4095;
        const int nwin = (s + 1 < w) ? s + 1 : w;
        float acc[8], u0[8];
#pragma unroll
        for (int i = 0; i < 8; ++i) acc[i] = 0.f;
        for (int j = 0; j < nwin; ++j) {
            const u32x4 v = *(const u32x4*)(z + (size_t)(tok - j) * ZW + c8);
            const float f[8] = {bflo(v.x), bfhi(v.x), bflo(v.y), bfhi(v.y), bflo(v.z), bfhi(v.z), bflo(v.w), bfhi(v.w)};
#pragma unroll
            for (int i = 0; i < 8; ++i) { acc[i] += f[i]; if (j == 0) u0[i] = f[i]; }
        }
        const float inv = 1.f / (float)nwin;
        u32x4 o; o.x = pk2(acc[0] * inv - u0[0], acc[1] * inv - u0[1]); o.y = pk2(acc[2] * inv - u0[2], acc[3] * inv - u0[3]);
        o.z = pk2(acc[4] * inv - u0[4], acc[5] * inv - u0[5]); o.w = pk2(acc[6] * inv - u0[6], acc[7] * inv - u0[7]);
        *(u32x4*)(mout + (size_t)tok * D + c8) = o;
    }
}

constexpr int HP = 136, VP = 72;
constexpr int L_QH = 0, L_QT = L_QH + 64 * HP * 2, L_KT = L_QT + 64 * HP * 2, L_VT = L_KT + 64 * HP * 2, L_P = L_VT + 128 * VP * 2, L_KTT = L_P + 64 * VP * 2,
              L_SEG = L_KTT + 128 * VP * 2, L_SSQ = L_SEG + 4 * 128 * 4, L_HEND = L_SSQ + 2 * 64 * 4;
static_assert(L_HEND <= 131072, "hgrn LDS map");
__device__ __forceinline__ void hgrn_gates(const bf16* z, size_t tok0, int hd, int d, int sg, float lb, float (&bl)[16], float (&kk)[16]) {
    float run = 0.f;
#pragma unroll
    for (int j = 0; j < 16; ++j) {
        float fz = bf1(z[(tok0 + sg * 16 + j) * ZW + 1024 + hd * 128 + d]);
        fz = fminf(fmaxf(fz, -60.f), 60.f);
        const float ls = (fz >= 0.f) ? -log1pf(expf(-fz)) : fz - log1pf(expf(fz));
        const float lf = ls + log1pf(lb * expf(-fz));
        kk[j] = (1.f - lb) / (1.f + expf(fz));
        run += lf; bl[j] = run;
    }
}
__device__ __forceinline__ float hgrn_lb(const float* lbl, int e, int ch) {
    if (e == 0) return 0.f;
    const float l0 = lbl[ch], l1 = lbl[512 + ch], mx = fmaxf(l0, l1), e0 = expf(l0 - mx), e1 = expf(l1 - mx);
    const float p0 = e0 / (e0 + e1), p1 = e1 / (e0 + e1);
    return fminf(fmaxf((p0 + p1) - p0, 0.f), 1.f);
}
__device__ __forceinline__ void hgrn_local_phase(LAS unsigned char* lds, const bf16* z, const float* lbl, int e, bf16* st, float* dec) {
    int tid = threadIdx.x; asm volatile("" : "+v"(tid)); const int lane = tid & 63, wave = __builtin_amdgcn_readfirstlane(tid >> 6); (void)lane; (void)wave;
    LAS bf16* kT = (LAS bf16*)(lds + L_KTT); LAS bf16* vT = (LAS bf16*)(lds + L_VT); LAS float* seg = (LAS float*)(lds + L_SEG);
    const int d = tid & 127, sg = tid >> 7, fr = lane & 15, fq = lane >> 4;
    for (int unit = blockIdx.x; unit < 2048; unit += gridDim.x) {
        const int n = unit & 63, bh = unit >> 6, hd = bh & 3, b = bh >> 2; const size_t tok0 = (size_t)b * 4096 + n * 64;
        const float lb = hgrn_lb(lbl, e, hd * 128 + d);
        float bl[16], kk[16];
        hgrn_gates(z, tok0, hd, d, sg, lb, bl, kk);
        __syncthreads();
        seg[sg * 128 + d] = bl[15];
        {
            unsigned wv[8];
#pragma unroll
            for (int j = 0; j < 8; ++j) { const unsigned a = z[(tok0 + sg * 16 + 2 * j) * ZW + 1536 + hd * 128 + d], c = z[(tok0 + sg * 16 + 2 * j + 1) * ZW + 1536 + hd * 128 + d]; wv[j] = a | (c << 16); }
            *(LAS u32x4*)(vT + d * VP + sg * 16) = (u32x4){wv[0], wv[1], wv[2], wv[3]}; *(LAS u32x4*)(vT + d * VP + sg * 16 + 8) = (u32x4){wv[4], wv[5], wv[6], wv[7]};
        }
        __syncthreads();
        float pre = 0.f, tot = 0.f;
#pragma unroll
        for (int s = 0; s < 4; ++s) { const float v = seg[s * 128 + d]; tot += v; if (s < sg) pre += v; }
        {
            unsigned wk[8];
#pragma unroll
            for (int j = 0; j < 8; ++j) { const float a = kk[2 * j] * expf(tot - (pre + bl[2 * j])), c = kk[2 * j + 1] * expf(tot - (pre + bl[2 * j + 1])); wk[j] = pk2(a, c); }
            *(LAS u32x4*)(kT + d * VP + sg * 16) = (u32x4){wk[0], wk[1], wk[2], wk[3]}; *(LAS u32x4*)(kT + d * VP + sg * 16 + 8) = (u32x4){wk[4], wk[5], wk[6], wk[7]};
        }
        if (sg == 0) dec[(size_t)unit * 128 + d] = expf(tot);
        __syncthreads();
        const int e0 = wave * 16;
        bf16x8 Vf[2];
#pragma unroll
        for (int ks = 0; ks < 2; ++ks) Vf[ks] = *(const LAS bf16x8*)(vT + (e0 + fr) * VP + ks * 32 + fq * 8);
#pragma unroll
        for (int dtile = 0; dtile < 8; ++dtile) {
            f32x4 acc = (f32x4){0.f, 0.f, 0.f, 0.f};
#pragma unroll
            for (int ks = 0; ks < 2; ++ks) { const bf16x8 Kf = *(const LAS bf16x8*)(kT + (dtile * 16 + fr) * VP + ks * 32 + fq * 8); acc = mfma16(Kf, Vf[ks], acc); }
            u32x2 o; o.x = pk2(acc[0], acc[1]); o.y = pk2(acc[2], acc[3]);
            *(u32x2*)(st + (size_t)unit * 16384 + (e0 + fr) * 128 + dtile * 16 + 4 * fq) = o;
        }
    }
}
__device__ __forceinline__ void hgrn_scan_phase(bf16* st, const float* dec) {
    int tid = threadIdx.x; asm volatile("" : "+v"(tid)); const int lane = tid & 63, wave = __builtin_amdgcn_readfirstlane(tid >> 6); (void)lane; (void)wave;
    const int gtid = blockIdx.x * NTHR + tid, ngt = gridDim.x * NTHR;
    for (int idx = gtid; idx < 32 * 4096; idx += ngt) {
        const int seq = idx >> 12, quad = idx & 4095, ee = quad >> 5, d4 = (quad & 31) * 4;
        float s0 = 0.f, s1 = 0.f, s2 = 0.f, s3 = 0.f;
#pragma unroll 8
        for (int n = 0; n < 64; ++n) {
            const int unit = seq * 64 + n;
            u32x2* p = (u32x2*)(st + (size_t)unit * 16384 + ee * 128 + d4);
            const u32x2 c = *p; const f32x4 dc = *(const f32x4*)(dec + (size_t)unit * 128 + d4);
            u32x2 o; o.x = pk2(s0, s1); o.y = pk2(s2, s3); *p = o;
            s0 = dc.x * s0 + bflo(c.x); s1 = dc.y * s1 + bfhi(c.x); s2 = dc.z * s2 + bflo(c.y); s3 = dc.w * s3 + bfhi(c.y);
        }
    }
}
__device__ __forceinline__ void hgrn_out_phase(LAS unsigned char* lds, const bf16* z, const float* lbl, int e, const bf16* st, const float* ogain, bf16* mout) {
    int tid = threadIdx.x; asm volatile("" : "+v"(tid)); const int lane = tid & 63, wave = __builtin_amdgcn_readfirstlane(tid >> 6); (void)lane; (void)wave;
    LAS bf16* qh = (LAS bf16*)(lds + L_QH); LAS bf16* qt = (LAS bf16*)(lds + L_QT); LAS bf16* kt = (LAS bf16*)(lds + L_KT);
    LAS bf16* vT = (LAS bf16*)(lds + L_VT); LAS bf16* P = (LAS bf16*)(lds + L_P); LAS float* seg = (LAS float*)(lds + L_SEG); LAS float* ssq = (LAS float*)(lds + L_SSQ);
    const int d = tid & 127, sg = tid >> 7, fr = lane & 15, fq = lane >> 4;
    for (int unit = blockIdx.x; unit < 2048; unit += gridDim.x) {
        const int n = unit & 63, bh = unit >> 6, hd = bh & 3, b = bh >> 2; const size_t tok0 = (size_t)b * 4096 + n * 64;
        const float lb = hgrn_lb(lbl, e, hd * 128 + d);
        float bl[16], kk[16];
        hgrn_gates(z, tok0, hd, d, sg, lb, bl, kk);
        __syncthreads();
        seg[sg * 128 + d] = bl[15];
        {
            unsigned wv[8];
#pragma unroll
            for (int j = 0; j < 8; ++j) { const unsigned a = z[(tok0 + sg * 16 + 2 * j) * ZW + 1536 + hd * 128 + d], c = z[(tok0 + sg * 16 + 2 * j + 1) * ZW + 1536 + hd * 128 + d]; wv[j] = a | (c << 16); }
            *(LAS u32x4*)(vT + d * VP + sg * 16) = (u32x4){wv[0], wv[1], wv[2], wv[3]}; *(LAS u32x4*)(vT + d * VP + sg * 16 + 8) = (u32x4){wv[4], wv[5], wv[6], wv[7]};
        }
        __syncthreads();
        float pre = 0.f;
#pragma unroll
        for (int s = 0; s < 4; ++s) { const float v = seg[s * 128 + d]; if (s < sg) pre += v; }
        const float ref = seg[d] + seg[128 + d];
#pragma unroll
        for (int j = 0; j < 16; ++j) {
            const int t = sg * 16 + j; const float bt = pre + bl[j];
            const float qv = bf1(z[(tok0 + t) * ZW + 512 + hd * 128 + d]);
            qh[t * HP + d] = (bf16)f2bf(qv * expf(bt));
            qt[t * HP + d] = (bf16)f2bf(qv * expf(bt - ref));
            kt[t * HP + d] = (bf16)f2bf(kk[j] * expf(ref - bt));
        }
        __syncthreads();
        {
            const int tt = wave >> 1;
#pragma unroll
            for (int i = 0; i < 2; ++i) {
                const int stl = (wave & 1) * 2 + i;
                f32x4 acc = (f32x4){0.f, 0.f, 0.f, 0.f};
                if (stl <= tt) {
#pragma unroll
                    for (int ks = 0; ks < 4; ++ks) { const bf16x8 Kf = *(const LAS bf16x8*)(kt + (stl * 16 + fr) * HP + ks * 32 + fq * 8), Qf = *(const LAS bf16x8*)(qt + (tt * 16 + fr) * HP + ks * 32 + fq * 8); acc = mfma16(Kf, Qf, acc); }
                }
                const int trow = tt * 16 + fr, s0 = stl * 16 + 4 * fq;
                float pv[4];
#pragma unroll
                for (int r = 0; r < 4; ++r) pv[r] = (stl <= tt && s0 + r <= trow) ? acc[r] : 0.f;
                u32x2 o; o.x = pk2(pv[0], pv[1]); o.y = pk2(pv[2], pv[3]);
                *(LAS u32x2*)(P + trow * VP + s0) = o;
            }
        }
        __syncthreads();
        const int tt = wave & 3, eh = wave >> 2, trow = tt * 16 + fr;
        f32x4 acc[4]; float ss = 0.f;
#pragma unroll
        for (int et = 0; et < 4; ++et) {
            const int e0 = eh * 64 + et * 16;
            acc[et] = (f32x4){0.f, 0.f, 0.f, 0.f};
#pragma unroll
            for (int ks = 0; ks < 4; ++ks) { const bf16x8 Sf = *(const bf16x8*)(st + (size_t)unit * 16384 + (e0 + fr) * 128 + ks * 32 + fq * 8), Qf = *(const LAS bf16x8*)(qh + trow * HP + ks * 32 + fq * 8); acc[et] = mfma16(Sf, Qf, acc[et]); }
#pragma unroll
            for (int ks = 0; ks < 2; ++ks) { const bf16x8 Vf = *(const LAS bf16x8*)(vT + (e0 + fr) * VP + ks * 32 + fq * 8), Pf = *(const LAS bf16x8*)(P + trow * VP + ks * 32 + fq * 8); acc[et] = mfma16(Vf, Pf, acc[et]); }
#pragma unroll
            for (int r = 0; r < 4; ++r) ss += acc[et][r] * acc[et][r];
        }
        ss += __shfl_xor(ss, 16); ss += __shfl_xor(ss, 32);
        if (fq == 0) ssq[eh * 64 + trow] = ss;
        __syncthreads();
        const float rstd = rsqrtf((ssq[trow] + ssq[64 + trow]) * (1.f / 128.f) + EPS);
#pragma unroll
        for (int et = 0; et < 4; ++et) {
            const int ec = eh * 64 + et * 16 + 4 * fq;
            const u32x2 gw2 = *(const u32x2*)(z + (tok0 + trow) * ZW + 2048 + hd * 128 + ec);
            const f32x4 og = *(const f32x4*)(ogain + ec);
            const float gv[4] = {bflo(gw2.x), bfhi(gw2.x), bflo(gw2.y), bfhi(gw2.y)};
            float ov[4];
#pragma unroll
            for (int r = 0; r < 4; ++r) { const float sl = gv[r] / (1.f + expf(-gv[r])); ov[r] = acc[et][r] * rstd * og[r] * sl; }
            u32x2 o; o.x = pk2(ov[0], ov[1]); o.y = pk2(ov[2], ov[3]);
            *(u32x2*)(mout + (tok0 + trow) * D + 512 + hd * 128 + ec) = o;
        }
    }
}

struct Args { const float* in[18]; float* out; unsigned char* ws; int ph_lo, ph_hi; };

__global__ void __launch_bounds__(NTHR, 2) trunk_fwd(Args args) {
    extern __shared__ __attribute__((aligned(16))) unsigned char lds_raw[];
    LAS unsigned char* lds = (LAS unsigned char*)lds_raw;
    cg::grid_group grid = cg::this_grid();
    const int tid = threadIdx.x, lane = tid & 63, wave = __builtin_amdgcn_readfirstlane(tid >> 6);
    const int G = gridDim.x, gw = blockIdx.x * 8 + wave, ngw = G * 8, gtid = blockIdx.x * NTHR + tid, ngt = G * NTHR;
    unsigned char* ws = args.ws;
    const float* x_in = args.in[0]; const float* mem = args.in[1]; const float* gains = args.in[2]; const float* memg = args.in[3];
    const float* w_in_ab = args.in[4]; const float* pool_w = args.in[5]; const float* pool_scale = args.in[6]; const float* lbl = args.in[7]; const float* rec_og = args.in[8];
    const float* w_out_ab = args.in[9]; const float* w_qkv = args.in[10]; const float* rel_bias = args.in[11]; const float* w_o_att = args.in[12];
    const float* w_mem_q = args.in[13]; const float* w_mem_kv = args.in[14]; const float* w_mem_o = args.in[15]; const float* w_ff1 = args.in[16]; const float* w_ff2 = args.in[17];
    float* xres = args.out;
    {
    bf16* Wb = (bf16*)(ws + WS_W); bf16* Hb = (bf16*)(ws + WS_H);
    bf16* Kmem = (bf16*)(ws + WS_MK); bf16* VTmem = (bf16*)(ws + WS_MV); bf16* memn = (bf16*)(ws + WS_MEMN);

    {
        LAS float* scr = (LAS float*)(lds + wave * 16384);
        int off = 0;
#define MAT(src, Ksrc, Nn, dst, ldt) { const int items = ((Ksrc) / 64) * ((Nn) / 32); const int first = ((gw - off) % ngw + ngw) % ngw; \
            for (int it = first; it < items; it += ngw) transpose_item((src), (Nn), (Nn) / 32, (dst), (ldt), scr, it, lane); off += items; }
        for (int l = 0; l < 4; ++l) {
            bf16* WL = Wb + (size_t)l * WL_STRIDE; const int eo = l >> 1;
            if ((l & 1) == 0) {
                MAT(w_in_ab + (size_t)eo * D * ZW, D, ZW, WL + WL_MIXIN, D)
                MAT(w_out_ab + (size_t)eo * D * D + (size_t)512 * D, 512, D, WL + WL_MIXOUT + 512, D)
            } else {
                MAT(w_qkv + (size_t)eo * D * 3072, D, 3072, WL + WL_MIXIN, D)
                MAT(w_o_att + (size_t)eo * D * D, D, D, WL + WL_MIXOUT, D)
            }
            MAT(w_mem_q + (size_t)l * D * D, D, D, WL + WL_MEMQ, D)
            MAT(w_mem_kv + (size_t)l * D * 2048, D, 2048, Wb + W_MEMKV + (size_t)l * 2048 * D, D)
            MAT(w_mem_o + (size_t)l * D * D, D, D, WL + WL_MEMO, D)
            MAT(w_ff1 + (size_t)l * D * FF, D, FF, WL + WL_FF1, D)
            MAT(w_ff2 + (size_t)l * FF * D, FF, D, WL + WL_FF2, FF)
        }
#undef MAT
        for (int idx = gtid; idx < 2 * 512 * 1024; idx += ngt) {
            const int nn = idx & 1023, kq = (idx >> 10) & 511, eo = idx >> 19, g = kq >> 7, c = kq & 127;
            const float* pw = pool_w + (((size_t)eo * 4 + g) * 128 + c) * 128; const float* ps = pool_scale + eo * 512 + g * 128;
            const float* wo = w_out_ab + (size_t)eo * D * D + (size_t)(g * 128) * D + nn;
            float a = 0.f;
            for (int dd = 0; dd < 128; ++dd) a += pw[dd] * ps[dd] * wo[(size_t)dd * D];
            Wb[(size_t)(2 * eo) * WL_STRIDE + WL_MIXOUT + (size_t)nn * D + kq] = (bf16)f2bf(a);
        }
        for (int r = gw; r < 2048; r += ngw) rms_row_to_bf16(mem + (size_t)r * D, memg, memn + (size_t)r * D, lane);
        for (int r = gw; r < T; r += ngw) rms_row_to_bf16(x_in + (size_t)r * D, gains, Hb + (size_t)r * D, lane);
        {
            float* par = (float*)(ws + WS_PAR);
            for (int i = gtid; i < PAR_N; i += ngt) par[i] = (i < PAR_LBL) ? gains[i] : (i < PAR_OG) ? lbl[i - PAR_LBL] : (i < PAR_RELB) ? rec_og[i - PAR_OG] : rel_bias[i - PAR_RELB];
        }
    }
    grid.sync();
    run_gemm<3>(lds, memn, Wb + W_MEMKV, 2048, 8192, D, Kmem, VTmem, nullptr, 0, 1.f);
    }

    for (int l = 0; l < 4; ++l) {
        unsigned char* wsl = args.ws; asm volatile("" : "+s"(wsl));
        bf16* Wb = (bf16*)(wsl + WS_W); bf16* Hb = (bf16*)(wsl + WS_H); bf16* R = (bf16*)(wsl + WS_R);
        bf16* Kmem = (bf16*)(wsl + WS_MK); bf16* VTmem = (bf16*)(wsl + WS_MV); float* decb = (float*)(wsl + WS_DEC);
        bf16* R0 = R; bf16* R64 = R + 32 * MiB; bf16* R128 = R + 64 * MiB; bf16* R192 = R + 96 * MiB;
        const float* par = (const float*)(wsl + WS_PAR);
        const bf16* WL = Wb + (size_t)l * WL_STRIDE; const float* gl = par + PAR_GAINS + (size_t)l * 6 * D; const int eo = l >> 1;
        const float* lblp = par + PAR_LBL; const float* ogp = par + PAR_OG + eo * 128; const float* relbp = par + PAR_RELB + (size_t)eo * 16 * 513;
        const float* xsrc = (l == 0) ? x_in : xres;
        if ((l & 1) == 0) {
            run_gemm<0>(lds, Hb, WL + WL_MIXIN, T, ZW, D, R0, nullptr, nullptr, ZW, 1.f);
            grid.sync();
            pool_phase(R0, R192);
            hgrn_local_phase(lds, R0, lblp, eo, Hb, decb);
            grid.sync();
            hgrn_scan_phase(Hb, decb);
            grid.sync();
            hgrn_out_phase(lds, R0, lblp, eo, Hb, ogp, R192);
            grid.sync();
        } else {
            run_gemm<2>(lds, Hb, WL + WL_MIXIN, T, 3072, D, R0, R64, R128, 1024, 0.125f);
            grid.sync();
            band_attn_phase(lds, R0, R64, R128, relbp, R192);
            grid.sync();
        }
        run_gemm<0>(lds, R192, WL + WL_MIXOUT, T, D, D, R0, nullptr, nullptr, D, 1.f);
        grid.sync();
        sweep_phase(R0, xsrc, xres, gl + 1 * D, gl + 2 * D, Hb);
        grid.sync();
        run_gemm<0>(lds, Hb, WL + WL_MEMQ, T, D, D, R64, nullptr, nullptr, D, 0.0625f);
        grid.sync();
        cross_attn_phase(lds, R64, Kmem + (size_t)l * 2048 * D, VTmem + (size_t)l * 8 * 1024 * 256, R128);
        grid.sync();
        run_gemm<0>(lds, R128, WL + WL_MEMO, T, D, D, R0, nullptr, nullptr, D, 1.f);
        grid.sync();
        sweep_phase(R0, xres, xres, gl + 3 * D, gl + 4 * D, Hb);
        grid.sync();
        run_gemm<1>(lds, Hb, WL + WL_FF1, T, FF, D, R0, nullptr, nullptr, FF, 1.f);
        grid.sync();
        run_gemm<0>(lds, R0, WL + WL_FF2, T, D, FF, Hb, nullptr, nullptr, D, 1.f);
        grid.sync();
        sweep_phase(Hb, xres, xres, gl + 5 * D, (l < 3) ? gl + 6 * D : gl, (l < 3) ? Hb : nullptr);
        grid.sync();
    }
}

extern "C" void kernel_launch(void* const* d_in, const int* in_sizes, int n_in, void* d_out, int out_size, void* d_ws, size_t ws_size, hipStream_t stream) {
    static int grid = 0;
    if (grid == 0) {
        if (n_in != 18 || out_size != T * D || ws_size < WS_END) { fprintf(stderr, "kernel_launch: unexpected shapes (n_in %d out %d ws %zu)\n", n_in, out_size, ws_size); grid = -1; return; }
        int dev = 0, cus = 0, per_cu = 0;
        hipGetDevice(&dev); hipDeviceGetAttribute(&cus, hipDeviceAttributeMultiprocessorCount, dev);
        hipFuncSetAttribute((const void*)trunk_fwd, hipFuncAttributeMaxDynamicSharedMemorySize, LDS_BYTES);
        hipOccupancyMaxActiveBlocksPerMultiprocessor(&per_cu, (const void*)trunk_fwd, NTHR, LDS_BYTES);
        if (per_cu < 1) { fprintf(stderr, "kernel_launch: occupancy query says %d blocks/CU\n", per_cu); per_cu = 1; }
        (void)hipGetLastError();
        grid = cus;
    }
    if (grid < 0) return;
    Args a{};
    for (int i = 0; i < 18; ++i) a.in[i] = (const float*)d_in[i];
    a.out = (float*)d_out; a.ws = (unsigned char*)d_ws; a.ph_lo = 0; a.ph_hi = 1000;
    void* kargs[] = {&a};
    hipError_t e = hipLaunchCooperativeKernel((const void*)trunk_fwd, dim3(grid), dim3(NTHR), kargs, LDS_BYTES, stream);
    if (e != hipSuccess) fprintf(stderr, "cooperative launch failed: %s (grid %d)\n", hipGetErrorString(e), grid);
}
```
